# Optimizing an MI355X kernel written in HIP

```python
import jax
import jax.numpy as jnp
from jax import lax
import numpy as np

D_MODEL = 1024
BATCH = 16
SEQ = 2048
DEPTH = 1
DEC_BATCH = 32
DEC_SEQ = 1
PAST_LEN = 16384
PAGE_SIZE = 128

POOL_WINDOWS = (2, 4, 8, 16)
POOL_GROUP = D_MODEL // 8
POOL_WIDTH = POOL_GROUP * len(POOL_WINDOWS)
POOL_STATE = max(POOL_WINDOWS) - 1
HEAD_DIM = 64
HEADS_PER_GROUP = 4
ATTN_GROUPS = ((128, 1), (512, 4), (2048, 16))
N_ATTN_GROUPS = len(ATTN_GROUPS)
GROUP_WIDTH = HEADS_PER_GROUP * HEAD_DIM
QKV_WIDTH = N_ATTN_GROUPS * 3 * GROUP_WIDTH
IN_WIDTH = POOL_WIDTH + QKV_WIDTH + 2 * D_MODEL
FFN_DIM = ((8 * D_MODEL // 3 + 127) // 128) * 128
ROPE_THETA = 10000.0
RMS_EPS = 1e-6
Q_BLOCK = 128
NEG_INF = -1e30

kernel_name = "hybrid_pool_dilated_attn_macaron_step"


def rmsnorm(x, g):
    xf = x.astype(jnp.float32)
    y = xf * lax.rsqrt(jnp.mean(xf * xf, axis=-1, keepdims=True) + RMS_EPS)
    return (y * g.astype(jnp.float32)).astype(x.dtype)


def swiglu(x, w_gate, w_up, w_down):
    return (jax.nn.silu(x @ w_gate) * (x @ w_up)) @ w_down


def apply_rope(t, pos):
    half = HEAD_DIM // 2
    inv = ROPE_THETA ** (-jnp.arange(half, dtype=jnp.float32) * (2.0 / HEAD_DIM))
    ang = pos.astype(jnp.float32)[:, None] * inv[None, :]
    cos = jnp.cos(ang)[None, :, None, :]
    sin = jnp.sin(ang)[None, :, None, :]
    tf = t.astype(jnp.float32)
    t1, t2 = tf[..., :half], tf[..., half:]
    return jnp.concatenate([t1 * cos - t2 * sin, t1 * sin + t2 * cos], axis=-1).astype(t.dtype)


def pool_mix(u_ext, pos, w_grp, scale):
    n, le, c = u_ext.shape
    L = le - POOL_STATE
    uf = u_ext.astype(jnp.float32)
    cs = jnp.concatenate([jnp.zeros((n, 1, c), jnp.float32), jnp.cumsum(uf, axis=1)], axis=1)
    tok = uf[:, POOL_STATE:]
    end = cs[:, POOL_STATE + 1:]
    groups = []
    for gi, w in enumerate(POOL_WINDOWS):
        lo, hi = gi * POOL_GROUP, (gi + 1) * POOL_GROUP
        begin = cs[:, POOL_STATE + 1 - w: POOL_STATE + 1 - w + L, lo:hi]
        cnt = jnp.minimum(pos + 1, w).astype(jnp.float32)[None, :, None]
        groups.append((end[..., lo:hi] - begin) / cnt - tok[..., lo:hi])
    p = jnp.stack(groups, axis=2)
    p = jnp.einsum('nlgc,gcd->nlgd', p, w_grp.astype(jnp.float32)).reshape(n, L, POOL_WIDTH)
    return (p * scale.astype(jnp.float32)).astype(u_ext.dtype)


def masked_softmax(sc, mask):
    sc = jnp.where(mask, sc, NEG_INF)
    mx = jnp.max(sc, axis=-1, keepdims=True)
    e = jnp.exp(sc - mx)
    den = jnp.sum(e, axis=-1, keepdims=True)
    return e / den, (mx + jnp.log(den))[..., 0]


def dilated_band_attention(q, k, v, window, dil):
    b, s, h, dh = q.shape
    nk = window // dil
    m = -(-s // dil)
    blk = min(Q_BLOCK, m)
    nb = -(-m // blk)
    mp = nb * blk

    def to_res(t):
        t = jnp.pad(t, ((0, 0), (0, m * dil - s), (0, 0), (0, 0)))
        return t.reshape(b, m, dil, h, dh).swapaxes(1, 2).reshape(b * dil, m, h, dh)

    qr = jnp.pad(to_res(q), ((0, 0), (0, mp - m), (0, 0), (0, 0)))
    kr = jnp.pad(to_res(k), ((0, 0), (nk, mp - m), (0, 0), (0, 0)))
    vr = jnp.pad(to_res(v), ((0, 0), (nk, mp - m), (0, 0), (0, 0)))
    kidx = jnp.arange(nb)[:, None] * blk + jnp.arange(blk + nk)[None, :]
    qb = qr.reshape(b * dil, nb, blk, h, dh).astype(jnp.float32)
    kb = kr[:, kidx].astype(jnp.float32)
    vb = vr[:, kidx].astype(jnp.float32)
    sc = jnp.einsum('nbqhd,nbkhd->nbhqk', qb, kb) * (HEAD_DIM ** -0.5)
    dist = jnp.arange(blk)[:, None] + nk - jnp.arange(blk + nk)[None, :]
    mask = ((dist >= 0) & (dist <= nk))[None] & (kidx >= nk)[:, None, :]
    p, lse = masked_softmax(sc, mask[None, :, None])
    o = jnp.einsum('nbhqk,nbkhd->nbqhd', p, vb)
    lse = lse.swapaxes(2, 3)

    def from_res(t):
        t = t.reshape((b, dil, mp) + t.shape[3:])[:, :, :m]
        t = t.swapaxes(1, 2).reshape((b, m * dil) + t.shape[3:])
        return t[:, :s]

    return from_res(o), from_res(lse)


def dilated_cached_attention(q, k_ext, v_ext, window, dil):
    t = q.shape[1]
    n_past = k_ext.shape[1] - t
    nk = window // dil
    kidx = n_past + jnp.arange(t)[:, None] - dil * jnp.arange(nk + 1)[None, :]
    mask = kidx >= 0
    kidx = jnp.maximum(kidx, 0)
    kb = k_ext[:, kidx].astype(jnp.float32)
    vb = v_ext[:, kidx].astype(jnp.float32)
    sc = jnp.einsum('nthd,ntkhd->nthk', q.astype(jnp.float32), kb) * (HEAD_DIM ** -0.5)
    p, lse = masked_softmax(sc, mask[None, :, None, :])
    o = jnp.einsum('nthk,ntkhd->nthd', p, vb)
    return o, lse


def decoder_layer(x, pos, pool_prefix, kv_prefix, lp):
    x = x + 0.5 * swiglu(rmsnorm(x, lp['norm_ffn1']), lp['ffn1_w_gate'], lp['ffn1_w_up'], lp['ffn1_w_down'])
    h = rmsnorm(x, lp['norm_mix'])
    n, L, _ = h.shape
    z = h @ lp['w_in']
    u = z[..., :POOL_WIDTH]
    qkv = z[..., POOL_WIDTH:POOL_WIDTH + QKV_WIDTH].reshape(n, L, N_ATTN_GROUPS, 3, HEADS_PER_GROUP, HEAD_DIM)
    gates = jax.nn.sigmoid(z[..., POOL_WIDTH + QKV_WIDTH:].astype(jnp.float32)).reshape(n, L, 2, D_MODEL)

    u_ext = jnp.concatenate([pool_prefix.astype(u.dtype), u], axis=1)
    pool = pool_mix(u_ext, pos, lp['w_pool_grp'], lp['pool_scale'])
    new_pool = u_ext[:, -POOL_STATE:]

    outs, lses, new_kv = [], [], []
    for g, (window, dil) in enumerate(ATTN_GROUPS):
        q = apply_rope(qkv[:, :, g, 0], pos)
        k = apply_rope(qkv[:, :, g, 1], pos)
        v = qkv[:, :, g, 2]
        if kv_prefix is None:
            o, lse = dilated_band_attention(q, k, v, window, dil)
            k_ext, v_ext = k, v
        else:
            buf = kv_prefix[g].astype(k.dtype)
            k_ext = jnp.concatenate([buf[:, :, 0], k], axis=1)
            v_ext = jnp.concatenate([buf[:, :, 1], v], axis=1)
            o, lse = dilated_cached_attention(q, k_ext, v_ext, window, dil)
        keep = min(window, k_ext.shape[1])
        new_kv.append(jnp.stack([k_ext[:, -keep:], v_ext[:, -keep:]], axis=2))
        outs.append(o)
        lses.append(lse)
    wts = jax.nn.softmax(jnp.stack(lses, axis=0), axis=0)
    attn = jnp.einsum('gnlh,gnlhd->nlhd', wts, jnp.stack(outs, axis=0))

    pool_br = (pool @ lp['w_pool_br']).astype(jnp.float32)
    attn_br = (attn.reshape(n, L, GROUP_WIDTH).astype(x.dtype) @ lp['w_attn_br']).astype(jnp.float32)
    merged = (gates[:, :, 0] * pool_br + gates[:, :, 1] * attn_br).astype(x.dtype)
    x = x + merged @ lp['w_o']
    x = x + 0.5 * swiglu(rmsnorm(x, lp['norm_ffn2']), lp['ffn2_w_gate'], lp['ffn2_w_up'], lp['ffn2_w_down'])
    return x, new_pool, new_kv


def setup_inputs(seed: int = 0) -> dict:
    key = jax.random.key(seed)
    ks = iter(jax.random.split(key, 32))
    f32 = jnp.float32

    def nrm(shape, scale):
        return scale * jax.random.normal(next(ks), shape, f32)

    def gain(shape):
        return 1.0 + 0.02 * jax.random.normal(next(ks), shape, f32)

    kv_shape = lambda w: (DEPTH, DEC_BATCH, min(w, PAST_LEN), 2, HEADS_PER_GROUP, HEAD_DIM)
    return {
        'x_prompt': nrm((BATCH, SEQ, D_MODEL), 1.0),
        'x_sample': nrm((DEC_BATCH, DEC_SEQ, D_MODEL), 1.0),
        'state_pool': nrm((DEPTH, DEC_BATCH, POOL_STATE, POOL_WIDTH), 1.0),
        'cache_kv_w128': nrm(kv_shape(ATTN_GROUPS[0][0]), 1.0),
        'cache_kv_w512': nrm(kv_shape(ATTN_GROUPS[1][0]), 1.0),
        'cache_kv_w2048': nrm(kv_shape(ATTN_GROUPS[2][0]), 1.0),
        'norm_ffn1': gain((DEPTH, D_MODEL)),
        'ffn1_w_gate': nrm((DEPTH, D_MODEL, FFN_DIM), D_MODEL ** -0.5),
        'ffn1_w_up': nrm((DEPTH, D_MODEL, FFN_DIM), D_MODEL ** -0.5),
        'ffn1_w_down': nrm((DEPTH, FFN_DIM, D_MODEL), FFN_DIM ** -0.5),
        'norm_mix': gain((DEPTH, D_MODEL)),
        'w_in': nrm((DEPTH, D_MODEL, IN_WIDTH), D_MODEL ** -0.5),
        'w_pool_grp': nrm((DEPTH, len(POOL_WINDOWS), POOL_GROUP, POOL_GROUP), POOL_GROUP ** -0.5),
        'pool_scale': gain((DEPTH, POOL_WIDTH)),
        'w_pool_br': nrm((DEPTH, POOL_WIDTH, D_MODEL), POOL_WIDTH ** -0.5),
        'w_attn_br': nrm((DEPTH, GROUP_WIDTH, D_MODEL), GROUP_WIDTH ** -0.5),
        'w_o': nrm((DEPTH, D_MODEL, D_MODEL), D_MODEL ** -0.5),
        'norm_ffn2': gain((DEPTH, D_MODEL)),
        'ffn2_w_gate': nrm((DEPTH, D_MODEL, FFN_DIM), D_MODEL ** -0.5),
        'ffn2_w_up': nrm((DEPTH, D_MODEL, FFN_DIM), D_MODEL ** -0.5),
        'ffn2_w_down': nrm((DEPTH, FFN_DIM, D_MODEL), FFN_DIM ** -0.5),
        'norm_final': gain((D_MODEL,)),
    }


def reference(x_prompt, x_sample, state_pool, cache_kv_w128, cache_kv_w512, cache_kv_w2048,
              norm_ffn1, ffn1_w_gate, ffn1_w_up, ffn1_w_down, norm_mix, w_in, w_pool_grp, pool_scale,
              w_pool_br, w_attn_br, w_o, norm_ffn2, ffn2_w_gate, ffn2_w_up, ffn2_w_down, norm_final):
    pos_p = jnp.arange(x_prompt.shape[1], dtype=jnp.int32)
    pos_s = PAST_LEN + jnp.arange(x_sample.shape[1], dtype=jnp.int32)
    hp, hs = x_prompt, x_sample
    pool_p, pool_s = [], []
    kv_p = [[] for _ in ATTN_GROUPS]
    kv_s = [[] for _ in ATTN_GROUPS]
    for l in range(DEPTH):
        lp = {
            'norm_ffn1': norm_ffn1[l], 'ffn1_w_gate': ffn1_w_gate[l], 'ffn1_w_up': ffn1_w_up[l],
            'ffn1_w_down': ffn1_w_down[l], 'norm_mix': norm_mix[l], 'w_in': w_in[l],
            'w_pool_grp': w_pool_grp[l], 'pool_scale': pool_scale[l], 'w_pool_br': w_pool_br[l],
            'w_attn_br': w_attn_br[l], 'w_o': w_o[l], 'norm_ffn2': norm_ffn2[l],
            'ffn2_w_gate': ffn2_w_gate[l], 'ffn2_w_up': ffn2_w_up[l], 'ffn2_w_down': ffn2_w_down[l],
        }
        zeros_pool = jnp.zeros((hp.shape[0], POOL_STATE, POOL_WIDTH), hp.dtype)
        hp, new_pool_p, new_kv_p = decoder_layer(hp, pos_p, zeros_pool, None, lp)
        hs, new_pool_s, new_kv_s = decoder_layer(
            hs, pos_s, state_pool[l], (cache_kv_w128[l], cache_kv_w512[l], cache_kv_w2048[l]), lp)
        pool_p.append(new_pool_p)
        pool_s.append(new_pool_s)
        for g in range(N_ATTN_GROUPS):
            kv_p[g].append(new_kv_p[g])
            kv_s[g].append(new_kv_s[g])
    y_prompt = rmsnorm(hp, norm_final)
    y_sample = rmsnorm(hs, norm_final)
    return (y_prompt, y_sample,
            jnp.stack(pool_p), jnp.stack(kv_p[0]), jnp.stack(kv_p[1]), jnp.stack(kv_p[2]),
            jnp.stack(pool_s), jnp.stack(kv_s[0]), jnp.stack(kv_s[1]), jnp.stack(kv_s[2]))
```

```cpp
#include <hip/hip_runtime.h>
#include <cstdio>
#include <cstdint>

#ifndef MK_N_LAUNCHES
#define MK_N_LAUNCHES 1
#endif

constexpr int DM = 1024, NB = 16, SEQ = 2048, NS = 32, PAST = 16384, FF = 2816, INW = 4864;
constexpr int MP = NB * SEQ;
constexpr int MT = MP + 256;
constexpr int QKVW = 2304, PW = 512, GW = 2048, AW = 256;
constexpr float RMS_EPS = 1e-6f;
constexpr float C2 = 0.125f * 1.4426950408889634f;

constexpr size_t O_YP = 0, O_YS = 33554432, O_POOLP = 33587200, O_KV128P = 33710080, O_KV512P = 34758656, O_KV2048P = 38952960,
                 O_POOLS = 55730176, O_KV128S = 55975936, O_KV512S = 58073088, O_KV2048S = 66461696, O_END = 100016128;

namespace pg8 {
#define PG8_LAS __attribute__((address_space(3)))
typedef unsigned short bf16_t;
typedef short bf16x8 __attribute__((ext_vector_type(8)));
typedef float f32x4 __attribute__((ext_vector_type(4)));
typedef float f32x2 __attribute__((ext_vector_type(2)));
typedef unsigned u32x4 __attribute__((ext_vector_type(4)));
typedef unsigned u32x2 __attribute__((ext_vector_type(2)));
constexpr int BM = 256, BK = 64, HALF = 128, HTB = HALF * BK * 2, STAGE_BYTES = 8 * HTB, NXCD = 8, WGM = 8;

__host__ __device__ __forceinline__ int lds_byte(int r, int c) { const int st = (r >> 4) * 2 + (c >> 5), rr = r & 15, cc = c & 31, ob = rr * 64 + cc * 2; return st * 1024 + (ob ^ (((ob >> 9) & 1) << 5)); }
__host__ __device__ __forceinline__ void stage_rc(int b, int& R, int& C) { const int st = b / 1024, sb = b % 1024, swz = sb ^ (((sb >> 9) & 1) << 5); R = (st >> 1) * 16 + swz / 64; C = (st & 1) * 32 + (swz % 64) / 2; }
__host__ __device__ __forceinline__ int perm32(int rho) { const int n = rho >> 4, i = rho & 15; return 8 * (i >> 2) + 4 * n + (i & 3); }

struct Unit { int pm, pn; };
struct Gemm { const bf16_t* A; const bf16_t* Bt; int M, N, K; size_t b_tile, b_half; };

struct StaticOrder {
    int nM, nN, nwg, G, c;
    __host__ __device__ void init(int M, int N, int G_, int c_) { nM = M / BM; nN = N / BM; nwg = nM * nN; G = G_; c = c_; }
    __host__ __device__ bool next(int i, Unit& u) const {
        const long L = (long)i * G + c; if (L >= nwg) return false;
        int wgid = (int)L; { const int q = nwg / NXCD, r = nwg % NXCD, xcd = wgid % NXCD, off = wgid / NXCD; wgid = (xcd < r ? xcd * (q + 1) : r * (q + 1) + (xcd - r) * q) + off; }
        const int nig = WGM * nN, gid = wgid / nig, fm = gid * WGM, gsz = (nM - fm) < WGM ? (nM - fm) : WGM;
        u.pm = fm + ((wgid % nig) % gsz); u.pn = (wgid % nig) / gsz; return true;
    }
};

typedef __bf16 bf16x2_t __attribute__((ext_vector_type(2)));
__device__ __forceinline__ unsigned cvt_pk_bf16(float lo, float hi) { const f32x2 v = {lo, hi}; const bf16x2_t b = __builtin_convertvector(v, bf16x2_t); return __builtin_bit_cast(unsigned, b); }

template <class Epi, class Sched, bool ALIGN_EPI = false, bool SP2 = false>
__device__ __forceinline__ void gemm_phase(PG8_LAS unsigned char* lds, const Gemm g, const Sched& S, const Epi& E) {
    const int tid = threadIdx.x, wid = __builtin_amdgcn_readfirstlane(tid >> 6), lane = tid & 63, wr = wid >> 2, wc = wid & 3, fr = lane & 15, fq = lane >> 4;
    const int K = g.K, nt = K / BK;
    unsigned voffA[2], voffB[2];
#pragma unroll
    for (int i = 0; i < 2; ++i) { int R, C; stage_rc(tid * 16 + i * 8192, R, C); int Rb = R;
        if constexpr (Epi::PERM == 1) Rb = (R & ~31) + perm32(R & 31);
        if constexpr (Epi::PERM == 2) Rb = (R & ~48) | (((R >> 4) & 1) << 5) | (((R >> 5) & 1) << 4);
        voffA[i] = (unsigned)(R * K + C) * 2u; voffB[i] = (unsigned)(Rb * K + C) * 2u; }
    const size_t kstep = (size_t)(BK * 2);
    const size_t hstep = (size_t)HALF * K * 2;
    const size_t tstep = 2 * hstep;
    const size_t bhstep = g.b_half * 2, btstep = g.b_tile * 2;
    const unsigned ldsw = (unsigned)wid * 1024u;
    const int aoff = lds_byte(wr * 64 + fr, fq * 8), boff = lds_byte(wc * 32 + fr, fq * 8);
#define PG8_SA(b, h) (((b) * 2 + (h)) * HTB)
#define PG8_SB(b, h) ((4 + (b) * 2 + (h)) * HTB)
#define PG8_STAGE(bufoff, gbase, voff) do { _Pragma("unroll") for (int _i = 0; _i < 2; ++_i) \
        __builtin_amdgcn_global_load_lds((const unsigned*)((const char*)(gbase) + (voff)[_i]), (PG8_LAS unsigned*)(lds + (bufoff) + ldsw + _i * 8192), 16, 0, 0); } while (0)
#define PG8_LDA(dst, b, h) do { _Pragma("unroll") for (int m = 0; m < 4; ++m) _Pragma("unroll") for (int k = 0; k < 2; ++k) dst[m][k] = *(const PG8_LAS bf16x8*)(lds + PG8_SA(b, h) + aoff + m * 2048 + k * 1024); } while (0)
#define PG8_LDB(dst, b, h) do { _Pragma("unroll") for (int n = 0; n < 2; ++n) _Pragma("unroll") for (int k = 0; k < 2; ++k) dst[n][k] = *(const PG8_LAS bf16x8*)(lds + PG8_SB(b, h) + boff + n * 2048 + k * 1024); } while (0)
#define PG8_MMA(ai, bj, At, Bt) do { __builtin_amdgcn_s_setprio(1); _Pragma("unroll") for (int m = 0; m < 4; ++m) _Pragma("unroll") for (int n = 0; n < 2; ++n) _Pragma("unroll") for (int k = 0; k < 2; ++k) \
        acc[ai][bj][m][n] = __builtin_amdgcn_mfma_f32_16x16x32_bf16(Bt[n][k], At[m][k], acc[ai][bj][m][n], 0, 0, 0); __builtin_amdgcn_s_setprio(0); } while (0)
#define PG8_WAIT_V(n) asm volatile("s_waitcnt vmcnt(" #n ")" ::: "memory")
#define PG8_WAIT_L(n) asm volatile("s_waitcnt lgkmcnt(" #n ")" ::: "memory")
#define PG8_BAR __builtin_amdgcn_s_barrier()
#define PG8_SCHED __builtin_amdgcn_sched_barrier(0)
    Unit cur, nxt; int ui = 0;
    if (!S.next(0, cur)) return;
    f32x4 acc[2][2][4][2];
#pragma unroll
    for (int a = 0; a < 2; ++a)
#pragma unroll
        for (int b = 0; b < 2; ++b)
#pragma unroll
            for (int m = 0; m < 4; ++m)
#pragma unroll
                for (int n = 0; n < 2; ++n) acc[a][b][m][n] = (f32x4){0.f, 0.f, 0.f, 0.f};
    bf16x8 At[4][2], B0[2][2], B1[2][2];
    const char* cA = (const char*)g.A + (size_t)cur.pm * tstep; const char* cB = (const char*)g.Bt + (size_t)cur.pn * btstep;
    if constexpr (SP2) {
        PG8_STAGE(PG8_SB(0, 0), cB, voffB); PG8_STAGE(PG8_SB(0, 1), cB + bhstep, voffB); PG8_STAGE(PG8_SA(0, 0), cA, voffA); PG8_STAGE(PG8_SA(0, 1), cA + hstep, voffA);
        if (wr == 1) PG8_BAR;
        PG8_WAIT_V(2); PG8_BAR;
        PG8_STAGE(PG8_SB(1, 0), cB + kstep, voffB); PG8_STAGE(PG8_SA(1, 0), cA + kstep, voffA); PG8_STAGE(PG8_SB(1, 1), cB + bhstep + kstep, voffB);
        PG8_WAIT_V(6); PG8_BAR;
    } else {
        PG8_STAGE(PG8_SB(0, 0), cB, voffB); PG8_STAGE(PG8_SA(0, 0), cA, voffA); PG8_STAGE(PG8_SB(0, 1), cB + bhstep, voffB); PG8_STAGE(PG8_SA(0, 1), cA + hstep, voffA);
        if (wr == 1) PG8_BAR;
        PG8_WAIT_V(4); PG8_BAR;
        PG8_STAGE(PG8_SB(1, 0), cB + kstep, voffB); PG8_STAGE(PG8_SA(1, 0), cA + kstep, voffA); PG8_STAGE(PG8_SB(1, 1), cB + bhstep + kstep, voffB);
        PG8_WAIT_V(6); PG8_BAR;
    }
    for (;;) {
        const bool has_next = S.next(ui + 1, nxt);
        const char* nA = has_next ? (const char*)g.A + (size_t)nxt.pm * tstep : cA; const char* nB = has_next ? (const char*)g.Bt + (size_t)nxt.pn * btstep : cB;
        for (int t = 0; t < nt; t += 2) {
            const bool last = (t == nt - 2);
            const char* a1 = cA + (size_t)(t + 1) * kstep;
            const char* a2 = last ? nA : cA + (size_t)(t + 2) * kstep; const char* b2 = last ? nB : cB + (size_t)(t + 2) * kstep;
            const char* a3 = a2 + kstep; const char* b3 = b2 + kstep;
            if constexpr (SP2) {
            PG8_LDB(B0, 0, 0); PG8_LDB(B1, 0, 1); PG8_SCHED; PG8_LDA(At, 0, 0); PG8_STAGE(PG8_SA(1, 1), a1 + hstep, voffA);
            PG8_WAIT_V(8); PG8_WAIT_L(0); PG8_BAR; PG8_MMA(0, 0, At, B0); PG8_MMA(0, 1, At, B1); PG8_BAR; PG8_SCHED;
            PG8_LDA(At, 0, 1); PG8_STAGE(PG8_SB(0, 0), b2, voffB); PG8_STAGE(PG8_SB(0, 1), b2 + bhstep, voffB); PG8_STAGE(PG8_SA(0, 0), a2, voffA);
            PG8_WAIT_V(8); PG8_WAIT_L(0); PG8_BAR; PG8_MMA(1, 0, At, B0); PG8_MMA(1, 1, At, B1); PG8_BAR; PG8_SCHED;
            PG8_LDB(B0, 1, 0); PG8_LDB(B1, 1, 1); PG8_SCHED; PG8_LDA(At, 1, 0); PG8_STAGE(PG8_SA(0, 1), a2 + hstep, voffA);
            PG8_WAIT_V(8); PG8_WAIT_L(0); PG8_BAR; PG8_MMA(0, 0, At, B0); PG8_MMA(0, 1, At, B1); PG8_BAR; PG8_SCHED;
            PG8_LDA(At, 1, 1); PG8_STAGE(PG8_SB(1, 0), b3, voffB); PG8_STAGE(PG8_SB(1, 1), b3 + bhstep, voffB); PG8_STAGE(PG8_SA(1, 0), a3, voffA);
            PG8_WAIT_V(8); PG8_WAIT_L(0); PG8_BAR; PG8_MMA(1, 0, At, B0); PG8_MMA(1, 1, At, B1); PG8_BAR; PG8_SCHED;
            } else {
            PG8_LDB(B0, 0, 0); PG8_SCHED; PG8_LDA(At, 0, 0); PG8_STAGE(PG8_SA(1, 1), a1 + hstep, voffA);
            PG8_WAIT_L(8); PG8_BAR; PG8_WAIT_L(0); PG8_MMA(0, 0, At, B0); PG8_BAR; PG8_SCHED;
            PG8_LDB(B1, 0, 1); PG8_STAGE(PG8_SB(0, 0), b2, voffB);
            PG8_BAR; PG8_WAIT_L(0); PG8_MMA(0, 1, At, B1); PG8_BAR;
            PG8_LDA(At, 0, 1); PG8_STAGE(PG8_SA(0, 0), a2, voffA);
            PG8_BAR; PG8_WAIT_L(0); PG8_MMA(1, 0, At, B0); PG8_BAR; PG8_SCHED;
            PG8_STAGE(PG8_SB(0, 1), b2 + bhstep, voffB);
            PG8_WAIT_V(6); PG8_BAR; PG8_MMA(1, 1, At, B1); PG8_BAR;
            PG8_LDB(B0, 1, 0); PG8_SCHED; PG8_LDA(At, 1, 0); PG8_STAGE(PG8_SA(0, 1), a2 + hstep, voffA);
            PG8_WAIT_L(8); PG8_BAR; PG8_WAIT_L(0); PG8_MMA(0, 0, At, B0); PG8_BAR; PG8_SCHED;
            PG8_LDB(B1, 1, 1); PG8_STAGE(PG8_SB(1, 0), b3, voffB);
            PG8_BAR; PG8_WAIT_L(0); PG8_MMA(0, 1, At, B1); PG8_BAR;
            PG8_LDA(At, 1, 1); PG8_STAGE(PG8_SA(1, 0), a3, voffA);
            PG8_BAR; PG8_WAIT_L(0); PG8_MMA(1, 0, At, B0); PG8_BAR; PG8_SCHED;
            PG8_STAGE(PG8_SB(1, 1), b3 + bhstep, voffB);
            PG8_WAIT_V(6); PG8_BAR; PG8_MMA(1, 1, At, B1); PG8_BAR;
            }
        }
        if constexpr (ALIGN_EPI) { if (wr == 0) PG8_BAR; }
        E(acc, cur, wr, wc, fr, fq);
        if (!has_next) break;
#pragma unroll
        for (int a = 0; a < 2; ++a)
#pragma unroll
            for (int b = 0; b < 2; ++b)
#pragma unroll
                for (int m = 0; m < 4; ++m)
#pragma unroll
                    for (int n = 0; n < 2; ++n) acc[a][b][m][n] = (f32x4){0.f, 0.f, 0.f, 0.f};
        cur = nxt; cA = nA; cB = nB; ++ui;
        if constexpr (ALIGN_EPI) { if (wr == 1) PG8_BAR; }
    }
    PG8_WAIT_V(0);
    if constexpr (!ALIGN_EPI) { if (wr == 0) PG8_BAR; }
    PG8_BAR;
#undef PG8_SA
#undef PG8_SB
#undef PG8_STAGE
#undef PG8_LDA
#undef PG8_LDB
#undef PG8_MMA
#undef PG8_WAIT_V
#undef PG8_WAIT_L
#undef PG8_BAR
#undef PG8_SCHED
}
}

using pg8::bf16_t; using pg8::f32x4; using pg8::u32x4; using pg8::u32x2; using pg8::bf16x8; using pg8::cvt_pk_bf16; using pg8::Unit;
typedef float f32x16 __attribute__((ext_vector_type(16)));
typedef short s16x4 __attribute__((ext_vector_type(4)));

#define GAS __attribute__((address_space(1)))
#define LAS __attribute__((address_space(3)))
typedef GAS unsigned gu32;
#define RLX_AGENT __ATOMIC_RELAXED, __HIP_MEMORY_SCOPE_AGENT

__device__ __forceinline__ float bf2f(unsigned short h) { return __uint_as_float((unsigned)h << 16); }
__device__ __forceinline__ float bflo(unsigned w) { return __uint_as_float(w << 16); }
__device__ __forceinline__ float bfhi(unsigned w) { return __uint_as_float(w & 0xffff0000u); }
__device__ __forceinline__ u32x2 pack4(f32x4 v) { u32x2 w; w.x = cvt_pk_bf16(v[0], v[1]); w.y = cvt_pk_bf16(v[2], v[3]); return w; }
__device__ __forceinline__ float rstd_of(const float* ss, int r) { return 1.0f / sqrtf(ss[r] * (1.0f / DM) + RMS_EPS); }
template <int NP> __device__ __forceinline__ float rstd_row(const float* ss, int r, int fq) {
    if (NP == 1) return rstd_of(ss, r);
    float q = (ss[(size_t)(4 * fq + 0) * MT + r] + ss[(size_t)(4 * fq + 1) * MT + r]) + (ss[(size_t)(4 * fq + 2) * MT + r] + ss[(size_t)(4 * fq + 3) * MT + r]);
    q += __shfl_xor(q, 16); q += __shfl_xor(q, 32);
    return 1.0f / sqrtf(q * (1.0f / DM) + RMS_EPS);
}
__device__ __forceinline__ float sigmoidf_(float v) { return __builtin_amdgcn_rcpf(1.0f + __builtin_amdgcn_exp2f(-1.4426950408889634f * v)); }

template <int NP> struct EpiUp {
    static constexpr int PERM = 1;
    bf16_t* H; const float* ss;
    __device__ __forceinline__ void operator()(const f32x4 (&acc)[2][2][4][2], const Unit& u, int wr, int wc, int fr, int fq) const {
        const int row0 = u.pm * 256 + wr * 64 + fr, col0 = u.pn * 128 + wc * 32 + 8 * fq;
#pragma unroll
        for (int ai = 0; ai < 2; ++ai)
#pragma unroll
            for (int m = 0; m < 4; ++m) {
                const int r = row0 + ai * 128 + m * 16; const float rs = rstd_row<NP>(ss, r, fq);
                f32x4 h[2];
#pragma unroll
                for (int n = 0; n < 2; ++n) { const f32x4 gt = acc[ai][0][m][n] * rs, up = acc[ai][1][m][n] * rs;
#pragma unroll
                    for (int e = 0; e < 4; ++e) h[n][e] = gt[e] * sigmoidf_(gt[e]) * up[e]; }
                u32x4 w; w.x = cvt_pk_bf16(h[0][0], h[0][1]); w.y = cvt_pk_bf16(h[0][2], h[0][3]); w.z = cvt_pk_bf16(h[1][0], h[1][1]); w.w = cvt_pk_bf16(h[1][2], h[1][3]);
                *(u32x4*)(H + (size_t)r * FF + col0) = w;
            }
    }
};

struct EpiRes {
    static constexpr int PERM = 0;
    const float* src_p; float* dst_p; float* xs; bf16_t* XB; float* ss_out; float scale;
    __device__ __forceinline__ void operator()(const f32x4 (&acc)[2][2][4][2], const Unit& u, int wr, int wc, int fr, int fq) const {
        const int row0 = u.pm * 256 + wr * 64 + fr, col0 = u.pn * 256 + wc * 32 + 4 * fq;
        const bool smp = (u.pm == MP / 256);
        const float* s = smp ? (const float*)xs - (size_t)MP * DM : src_p; float* d = smp ? xs - (size_t)MP * DM : dst_p;
#pragma unroll
        for (int ai = 0; ai < 2; ++ai)
#pragma unroll
            for (int m = 0; m < 4; ++m) {
                const int r = row0 + ai * 128 + m * 16; const size_t off = (size_t)r * DM + col0; float q = 0.f;
#pragma unroll
                for (int bj = 0; bj < 2; ++bj)
#pragma unroll
                    for (int n = 0; n < 2; ++n) { const size_t o = off + bj * 128 + n * 16; const f32x4 x = *(const f32x4*)(s + o);
                        const f32x4 v = x + acc[ai][bj][m][n] * scale;
                        *(f32x4*)(d + o) = v; if (XB) *(u32x2*)(XB + o) = pack4(v);
                        q += (v[0] * v[0] + v[1] * v[1]) + (v[2] * v[2] + v[3] * v[3]); }
                q += __shfl_xor(q, 16); q += __shfl_xor(q, 32);
                if (fq == 0) ss_out[(size_t)(u.pn * 4 + wc) * MT + r] = q;
            }
    }
};

__device__ __forceinline__ void sincos_rev(float ang, float& s, float& c) {
    const float C_hi = 0.15915494f, C_lo = 6.4206383e-09f;
    const float p = ang * C_hi; float e = __builtin_fmaf(ang, C_hi, -p); e = __builtin_fmaf(ang, C_lo, e);
    const float f = __builtin_amdgcn_fractf(p) + e;
    s = __builtin_amdgcn_sinf(f); c = __builtin_amdgcn_cosf(f);
}

struct EpiIn {
    static constexpr int PERM = 2;
    const float* ss; bf16_t* U; bf16_t* QKV; bf16_t* G; float* out;
    __device__ __forceinline__ void operator()(const f32x4 (&acc)[2][2][4][2], const Unit& u, int wr, int wc, int fr, int fq) const {
        const int row0 = u.pm * 256 + wr * 64 + fr;
        const int hsel = wc >> 1, dlo = 16 * (wc & 1) + 4 * fq;
        const int cb = 64 * hsel + dlo;
        const int pn = u.pn;
        if (pn < 2) {
#pragma unroll
            for (int ai = 0; ai < 2; ++ai)
#pragma unroll
                for (int m = 0; m < 4; ++m) {
                    const int r = row0 + ai * 128 + m * 16; const float rs = rstd_row<16>(ss, r, fq);
                    const int t = r & (SEQ - 1), b = r >> 11; float* po = nullptr;
                    if (r < MP) { if (t >= SEQ - 15) po = out + O_POOLP + (size_t)(b * 15 + (t - (SEQ - 15))) * PW; }
                    else if (r < MP + NS) po = out + O_POOLS + (size_t)((r - MP) * 15 + 14) * PW;
#pragma unroll
                    for (int bj = 0; bj < 2; ++bj)
#pragma unroll
                        for (int n = 0; n < 2; ++n) { const int c = pn * 256 + 128 * bj + 32 * n + cb; const f32x4 v = acc[ai][bj][m][n] * rs;
                            *(u32x2*)(U + (size_t)r * PW + c) = pack4(v); if (po) *(f32x4*)(po + c) = v; }
                }
        } else if (pn < 11) {
            const int j = pn - 2, g = j / 3, which = j - 3 * g;
            const int W = 128 << (2 * g);
            const size_t okp = (g == 0) ? O_KV128P : (g == 1) ? O_KV512P : O_KV2048P, oks = (g == 0) ? O_KV128S : (g == 1) ? O_KV512S : O_KV2048S;
            float inv[4];
#pragma unroll
            for (int e = 0; e < 4; ++e) inv[e] = __builtin_amdgcn_exp2f(-(float)(dlo + e) * (13.287712379549449f / 32.0f));
#pragma unroll
            for (int ai = 0; ai < 2; ++ai)
#pragma unroll
                for (int m = 0; m < 4; ++m) {
                    const int r = row0 + ai * 128 + m * 16; const float rs = rstd_row<16>(ss, r, fq);
                    const int t = r & (SEQ - 1), b = r >> 11; float* kvo = nullptr;
                    if (which != 0) {
                        if (r < MP) { if (t >= SEQ - W) kvo = out + okp + ((size_t)(b * W + (t - (SEQ - W))) * 2 + (which - 1)) * 256; }
                        else if (r < MP + NS) kvo = out + oks + ((size_t)((r - MP) * W + (W - 1)) * 2 + (which - 1)) * 256;
                    }
                    bf16_t* qrow = QKV + (size_t)r * QKVW + g * 768 + which * 256;
                    if (which == 2) {
#pragma unroll
                        for (int bj = 0; bj < 2; ++bj)
#pragma unroll
                            for (int n = 0; n < 2; ++n) { const int hd = (2 * bj + hsel) * 64 + 32 * n + dlo; const f32x4 v = acc[ai][bj][m][n] * rs;
                                *(u32x2*)(qrow + hd) = pack4(v); if (kvo) *(f32x4*)(kvo + hd) = v; }
                    } else {
                        const float pos = (r < MP) ? (float)t : (float)PAST;
                        f32x4 cs, sn;
#pragma unroll
                        for (int e = 0; e < 4; ++e) { float s_, c_; sincos_rev(pos * inv[e], s_, c_); cs[e] = c_; sn[e] = s_; }
                        const float sc = (which == 0) ? rs * C2 : rs;
#pragma unroll
                        for (int bj = 0; bj < 2; ++bj) { const int hd = (2 * bj + hsel) * 64 + dlo; const f32x4 t1 = acc[ai][bj][m][0] * sc, t2 = acc[ai][bj][m][1] * sc;
                            const f32x4 o1 = t1 * cs - t2 * sn, o2 = t1 * sn + t2 * cs;
                            *(u32x2*)(qrow + hd) = pack4(o1); *(u32x2*)(qrow + hd + 32) = pack4(o2);
                            if (kvo) { *(f32x4*)(kvo + hd) = o1; *(f32x4*)(kvo + hd + 32) = o2; } }
                    }
                }
        } else {
#pragma unroll
            for (int ai = 0; ai < 2; ++ai)
#pragma unroll
                for (int m = 0; m < 4; ++m) {
                    const int r = row0 + ai * 128 + m * 16; const float rs = rstd_row<16>(ss, r, fq);
#pragma unroll
                    for (int bj = 0; bj < 2; ++bj)
#pragma unroll
                        for (int n = 0; n < 2; ++n) { const int c = (pn - 11) * 256 + 128 * bj + 32 * n + cb; const f32x4 v = acc[ai][bj][m][n] * rs; f32x4 sg;
#pragma unroll
                            for (int e = 0; e < 4; ++e) sg[e] = sigmoidf_(v[e]);
                            *(u32x2*)(G + (size_t)r * GW + c) = pack4(sg); }
                }
        }
    }
};

template <int SECOND> struct EpiBr {
    static constexpr int PERM = 1;
    const bf16_t* G; bf16_t* T1; bf16_t* MG;
    __device__ __forceinline__ void operator()(const f32x4 (&acc)[2][2][4][2], const Unit& u, int wr, int wc, int fr, int fq) const {
        const int row0 = u.pm * 256 + wr * 64 + fr, col0 = u.pn * 256 + wc * 32 + 8 * fq;
#pragma unroll
        for (int ai = 0; ai < 2; ++ai)
#pragma unroll
            for (int m = 0; m < 4; ++m) {
                const int r = row0 + ai * 128 + m * 16;
#pragma unroll
                for (int bj = 0; bj < 2; ++bj) { const int c = col0 + bj * 128;
                    const u32x4 gw = *(const u32x4*)(G + (size_t)r * GW + SECOND * DM + c);
                    const f32x4 a0 = acc[ai][bj][m][0], a1 = acc[ai][bj][m][1];
                    float v[8] = {a0[0] * bflo(gw.x), a0[1] * bfhi(gw.x), a0[2] * bflo(gw.y), a0[3] * bfhi(gw.y), a1[0] * bflo(gw.z), a1[1] * bfhi(gw.z), a1[2] * bflo(gw.w), a1[3] * bfhi(gw.w)};
                    if (SECOND) { const u32x4 tw = *(const u32x4*)(T1 + (size_t)r * DM + c);
                        v[0] += bflo(tw.x); v[1] += bfhi(tw.x); v[2] += bflo(tw.y); v[3] += bfhi(tw.y); v[4] += bflo(tw.z); v[5] += bfhi(tw.z); v[6] += bflo(tw.w); v[7] += bfhi(tw.w); }
                    u32x4 w; w.x = cvt_pk_bf16(v[0], v[1]); w.y = cvt_pk_bf16(v[2], v[3]); w.z = cvt_pk_bf16(v[4], v[5]); w.w = cvt_pk_bf16(v[6], v[7]);
                    *(u32x4*)((SECOND ? MG : T1) + (size_t)r * DM + c) = w; }
            }
    }
};

constexpr size_t MiB = 1u << 20;
constexpr size_t WS_CTL = 0, CTL_ZERO_BYTES = 1 * MiB;
constexpr int CW_BAR = 4096;
constexpr int CW_SS = 16384;
static_assert((CW_SS + MT) * 4 <= (int)CTL_ZERO_BYTES, "ctl");
constexpr size_t WS_W1UP = 1 * MiB;
constexpr size_t WS_W1DN = WS_W1UP + (size_t)2 * FF * DM * 2;
constexpr size_t WS_WIN = WS_W1DN + (size_t)DM * FF * 2;
constexpr size_t WS_WCOMB = WS_WIN + (size_t)INW * DM * 2;
constexpr size_t WS_WAB = WS_WCOMB + (size_t)DM * PW * 2;
constexpr size_t WS_WO = WS_WAB + (size_t)DM * AW * 2;
constexpr size_t WS_W2UP = WS_WO + (size_t)DM * DM * 2;
constexpr size_t WS_W2DN = WS_W2UP + (size_t)2 * FF * DM * 2;
constexpr size_t WS_XS = WS_W2DN + (size_t)DM * FF * 2;
constexpr size_t WS_XB = WS_XS + (size_t)256 * DM * 4;
constexpr size_t WS_OG = WS_XB;
constexpr size_t WS_LSE = WS_OG + (size_t)MT * 768 * 2;
constexpr size_t WS_Z = WS_XB + (size_t)MT * DM * 2;
static_assert(WS_LSE + (size_t)MT * 12 * 4 <= WS_Z, "OG/LSE overlay fits in XB");
constexpr size_t WS_H = WS_Z;
constexpr size_t WS_U = WS_Z;
constexpr size_t WS_QKV = WS_U + (size_t)MT * PW * 2;
constexpr size_t WS_T1 = WS_QKV, WS_MG = WS_QKV + (size_t)MT * DM * 2;
constexpr size_t WS_G = WS_QKV + (size_t)MT * QKVW * 2;
static_assert(WS_MG + (size_t)MT * DM * 2 <= WS_G, "T1/MG overlay fits in QKV");
constexpr size_t WS_P = WS_G + (size_t)MT * GW * 2;
static_assert(WS_H + (size_t)MT * FF * 2 <= WS_P, "H overlay fits in Z");
constexpr size_t WS_ATT = WS_P + (size_t)MT * PW * 2;
constexpr size_t WS_SSP = WS_ATT + (size_t)MT * AW * 2;
constexpr size_t SSP_STRIDE = (size_t)16 * MT;
constexpr size_t WS_END = WS_SSP + 3 * SSP_STRIDE * 4;

constexpr int RING_OFF = 0, RING_BYTES = 131072;
constexpr int LDSCTL_OFF = RING_BYTES, MISC_OFF = LDSCTL_OFF + 320;
constexpr int LDS_BYTES = 147456;
constexpr int NWAVES = 8;

#define XB_TMO      128
#define XB_XCNT(j)  (256  + 64 * (j))
#define XB_XSUB(j)  (1280 + 64 * (j))
#define XB_XGEN(j)  (2304 + 64 * (j))
#define XB_TOP      3328
#define XB_TOPGEN   3392
#define XCD_BAR_WORDS 3456
#define XB_SPIN_CAP (1u << 18)
__device__ __forceinline__ unsigned xb_ld(unsigned* p)              { return __hip_atomic_load(p, __ATOMIC_RELAXED, __HIP_MEMORY_SCOPE_AGENT); }
__device__ __forceinline__ unsigned xb_add(unsigned* p, unsigned v) { return __hip_atomic_fetch_add(p, v, __ATOMIC_RELAXED, __HIP_MEMORY_SCOPE_AGENT); }
__device__ __forceinline__ unsigned xb_xcc_id() { return (unsigned)__builtin_amdgcn_s_getreg((3 << 11) | 20) & 0xFu; }
#define XB_SPIN(cond, bar) do { unsigned _sp = 0; while (cond) { __builtin_amdgcn_s_sleep(1); \
    if ((++_sp & 255u) == 0u) { if (xb_ld(&(bar)[XB_TMO])) break; if (_sp > XB_SPIN_CAP) { atomicAdd(&(bar)[XB_TMO], 1u); break; } } } } while (0)
struct XcdBarrier { unsigned* bar; unsigned x; volatile LAS unsigned* st; };
__device__ __forceinline__ XcdBarrier xcd_barrier_post(unsigned* bar, volatile LAS unsigned* st) {
    XcdBarrier b; b.bar = bar; b.x = xb_xcc_id(); b.st = st;
    if (threadIdx.x == 0) (void)xb_add(&bar[XB_XCNT(b.x)], 1u);
    return b;
}
__device__ __forceinline__ void xcd_barrier_complete(unsigned* bar, unsigned x, unsigned& nloc, unsigned& nx) {
    const unsigned G = gridDim.x * gridDim.y * gridDim.z;
    unsigned sum, cnt, mine, sp = 0u;
    for (;;) {
        sum = 0u; cnt = 0u; mine = 0u;
#pragma unroll
        for (unsigned j = 0; j < 16; ++j) { const unsigned c = xb_ld(&bar[XB_XCNT(j)]); sum += c; cnt += (c > 0u) ? 1u : 0u; mine = (j == x) ? c : mine; }
        if (sum == G) break;
        __builtin_amdgcn_s_sleep(1);
        if ((++sp & 255u) == 0u) { if (xb_ld(&bar[XB_TMO])) break; if (sp > XB_SPIN_CAP) { atomicAdd(&bar[XB_TMO], 1u); break; } }
    }
    nloc = mine > 0u ? mine : 1u; nx = cnt > 0u ? cnt : 1u;
}
__device__ __forceinline__ void xcd_barrier(const XcdBarrier& b) {
    asm volatile("s_waitcnt vmcnt(0)" ::: "memory");
    __syncthreads();
    if (threadIdx.x == 0) {
        unsigned* bar = b.bar;
        __builtin_amdgcn_s_waitcnt(0);
        unsigned nloc = b.st[0], nx = b.st[1];
        if (nloc == 0u) { xcd_barrier_complete(bar, b.x, nloc, nx); b.st[0] = nloc; b.st[1] = nx; }
        const unsigned old = xb_add(&bar[XB_XSUB(b.x)], 1u);
        const unsigned gen = old / nloc;
        if (old + 1u == (gen + 1u) * nloc) {
            __builtin_amdgcn_fence(__ATOMIC_RELEASE, "agent");
            asm volatile("s_waitcnt vmcnt(0)" ::: "memory");
            const unsigned og = xb_add(&bar[XB_TOP], 1u);
            const unsigned tg = og / nx;
            if (og + 1u == (tg + 1u) * nx) xb_add(&bar[XB_TOPGEN], 1u);
            else XB_SPIN(xb_ld(&bar[XB_TOPGEN]) == tg, bar);
            __builtin_amdgcn_fence(__ATOMIC_ACQUIRE, "agent");
            xb_add(&bar[XB_XGEN(b.x)], 1u);
            asm volatile("s_waitcnt vmcnt(0)" ::: "memory");
        } else {
            XB_SPIN(xb_ld(&bar[XB_XGEN(b.x)]) == gen, bar);
            __builtin_amdgcn_fence(__ATOMIC_ACQUIRE, "agent");
            asm volatile("s_waitcnt vmcnt(0)" ::: "memory");
        }
    }
    __syncthreads();
}

struct Args { const float* in[22]; float* out; unsigned char* ws; int ph_lo, ph_hi; };
struct Frame {
    LAS unsigned char* lds; int tid, lane, wave, vcu, G;
};
#define LDS_WAIT() asm volatile("s_waitcnt lgkmcnt(0)" ::: "memory")

__device__ __forceinline__ void p0_transpose_item(const float* W, const float* gain, int K, int N, bf16_t* WT, int row_off, LAS float* scr, int item, int lane) {
    const int nblk = N / 32, kb = item / nblk, nb = item % nblk, k0 = 64 * kb, n0 = 32 * nb;
#pragma unroll 8
    for (int i = 0; i < 32; ++i) { const int kk = 2 * i + (lane >> 5); float v = W[(size_t)(k0 + kk) * N + n0 + (lane & 31)]; if (gain) v *= gain[k0 + kk]; scr[kk * 33 + (lane & 31)] = v; }
    LDS_WAIT(); asm volatile("" ::: "memory");
    const int c = lane & 7;
#pragma unroll
    for (int j = 0; j < 4; ++j) { const int n = (lane >> 3) + 8 * j; const LAS float* s = scr + (8 * c) * 33 + n;
        u32x4 o; o.x = cvt_pk_bf16(s[0 * 33], s[1 * 33]); o.y = cvt_pk_bf16(s[2 * 33], s[3 * 33]); o.z = cvt_pk_bf16(s[4 * 33], s[5 * 33]); o.w = cvt_pk_bf16(s[6 * 33], s[7 * 33]);
        *(u32x4*)(WT + (size_t)(row_off + n0 + n) * K + k0 + 8 * c) = o; }
    LDS_WAIT(); asm volatile("" ::: "memory");
}
__device__ __forceinline__ float wave_sum(float v) {
#pragma unroll
    for (int o = 1; o < 64; o <<= 1) v += __shfl_xor(v, o);
    return v;
}

__device__ __forceinline__ void p0_prologue(const Frame& F, const Args& a) {
    unsigned char* ws = a.ws;
    LAS float* scr = (LAS float*)(F.lds + RING_OFF + F.wave * 16384);
    const int gw = F.vcu * NWAVES + F.wave, NGW = F.G * NWAVES;
    constexpr int I_UP = (DM / 64) * (FF / 32), I_DN = (FF / 64) * (DM / 32), I_IN = (DM / 64) * (INW / 32), I_AB = (AW / 64) * (DM / 32), I_O = (DM / 64) * (DM / 32), I_CMB = 1024;
    constexpr int NITEMS = 4 * I_UP + 2 * I_DN + I_IN + I_AB + I_O + I_CMB;
    for (int it = gw; it < NITEMS; it += NGW) {
        int r = it;
        if (r < I_UP) { p0_transpose_item(a.in[7], a.in[6], DM, FF, (bf16_t*)(ws + WS_W1UP), 0, scr, r, F.lane); continue; } r -= I_UP;
        if (r < I_UP) { p0_transpose_item(a.in[8], a.in[6], DM, FF, (bf16_t*)(ws + WS_W1UP), FF, scr, r, F.lane); continue; } r -= I_UP;
        if (r < I_DN) { p0_transpose_item(a.in[9], nullptr, FF, DM, (bf16_t*)(ws + WS_W1DN), 0, scr, r, F.lane); continue; } r -= I_DN;
        if (r < I_IN) { p0_transpose_item(a.in[11], a.in[10], DM, INW, (bf16_t*)(ws + WS_WIN), 0, scr, r, F.lane); continue; } r -= I_IN;
        if (r < I_AB) { p0_transpose_item(a.in[15], nullptr, AW, DM, (bf16_t*)(ws + WS_WAB), 0, scr, r, F.lane); continue; } r -= I_AB;
        if (r < I_O) { p0_transpose_item(a.in[16], nullptr, DM, DM, (bf16_t*)(ws + WS_WO), 0, scr, r, F.lane); continue; } r -= I_O;
        if (r < I_UP) { p0_transpose_item(a.in[18], a.in[17], DM, FF, (bf16_t*)(ws + WS_W2UP), 0, scr, r, F.lane); continue; } r -= I_UP;
        if (r < I_UP) { p0_transpose_item(a.in[19], a.in[17], DM, FF, (bf16_t*)(ws + WS_W2UP), FF, scr, r, F.lane); continue; } r -= I_UP;
        if (r < I_DN) { p0_transpose_item(a.in[20], nullptr, FF, DM, (bf16_t*)(ws + WS_W2DN), 0, scr, r, F.lane); continue; } r -= I_DN;
        {
            const int nb = r & 15, kc = r >> 4, k0 = kc * 8, g = k0 >> 7, c0 = k0 & 127, n = nb * 64 + F.lane;
            const float* wgrp = a.in[12] + (size_t)(g * 128 + c0) * 128; const float* scl = a.in[13] + g * 128; const float* wpb = a.in[14] + (size_t)(g * 128) * DM + n;
            float ac[8] = {0.f, 0.f, 0.f, 0.f, 0.f, 0.f, 0.f, 0.f};
            for (int d = 0; d < 128; ++d) { const float wv = wpb[(size_t)d * DM] * scl[d];
#pragma unroll
                for (int i = 0; i < 8; ++i) ac[i] += wgrp[i * 128 + d] * wv; }
            u32x4 o; o.x = cvt_pk_bf16(ac[0], ac[1]); o.y = cvt_pk_bf16(ac[2], ac[3]); o.z = cvt_pk_bf16(ac[4], ac[5]); o.w = cvt_pk_bf16(ac[6], ac[7]);
            *(u32x4*)((bf16_t*)(ws + WS_WCOMB) + (size_t)n * PW + k0) = o;
        }
    }
    float* ss0 = (float*)(ws + WS_CTL) + CW_SS;
    for (int m = gw; m < MP + NS; m += NGW) {
        const float* xr = (m < MP) ? a.in[0] + (size_t)m * DM : a.in[1] + (size_t)(m - MP) * DM;
        const f32x4* x4 = (const f32x4*)xr + F.lane; f32x4 v[4]; float s = 0.f;
#pragma unroll
        for (int j = 0; j < 4; ++j) { v[j] = x4[64 * j]; s += (v[j].x * v[j].x + v[j].y * v[j].y) + (v[j].z * v[j].z + v[j].w * v[j].w); }
        s = wave_sum(s);
        u32x2* o8 = (u32x2*)((bf16_t*)(ws + WS_XB) + (size_t)m * DM) + F.lane;
#pragma unroll
        for (int j = 0; j < 4; ++j) o8[64 * j] = pack4(v[j]);
        if (m >= MP) { f32x4* xs4 = (f32x4*)((float*)(ws + WS_XS) + (size_t)(m - MP) * DM) + F.lane;
#pragma unroll
            for (int j = 0; j < 4; ++j) xs4[64 * j] = v[j]; }
        if (F.lane == 0) ss0[m] = s;
    }
    const size_t gt = (size_t)F.vcu * (NWAVES * 64) + F.tid, NT = (size_t)F.G * NWAVES * 64;
#define COPY_SHIFT(src, dstoff, ROWS, RW4) do { const f32x4* s4 = (const f32x4*)(src); f32x4* d4 = (f32x4*)(a.out + (dstoff)); \
        const size_t per = (size_t)((ROWS) - 1) * (RW4), tot = (size_t)NS * per; \
        for (size_t i = gt; i < tot; i += NT) { const size_t n = i / per, rem = i - n * per; d4[n * (size_t)(ROWS) * (RW4) + rem] = s4[n * (size_t)(ROWS) * (RW4) + (RW4) + rem]; } } while (0)
    COPY_SHIFT(a.in[5], O_KV2048S, 2048, 128);
    COPY_SHIFT(a.in[4], O_KV512S, 512, 128);
    COPY_SHIFT(a.in[3], O_KV128S, 128, 128);
    COPY_SHIFT(a.in[2], O_POOLS, 15, 128);
#undef COPY_SHIFT
}

namespace att {
__device__ __forceinline__ int crow(int r, int hi) { return (r & 3) + 8 * (r >> 2) + 4 * hi; }
typedef short v4i16_t __attribute__((ext_vector_type(4)));
__device__ __forceinline__ s16x4 vtr(LAS const unsigned char* p) { return __builtin_bit_cast(s16x4, __builtin_amdgcn_ds_read_tr16_b64_v4i16((LAS v4i16_t*)p)); }
__device__ __forceinline__ float swapmax(float m) { auto rr = __builtin_amdgcn_permlane32_swap(__float_as_uint(m), __float_as_uint(m), false, false); return fmaxf(__uint_as_float(rr[0]), __uint_as_float(rr[1])); }
__device__ __forceinline__ float swapsum(float m) { auto rr = __builtin_amdgcn_permlane32_swap(__float_as_uint(m), __float_as_uint(m), false, false); return __uint_as_float(rr[0]) + __uint_as_float(rr[1]); }

__device__ __forceinline__ void task(const bf16_t* QKV, int colq, long kbase, int kstride, int qs0, int tlo, int thi, LAS unsigned char* vb,
                                     bf16_t* OGp  , float* LSEp  , int lane) {
    const int r32 = lane & 31, hi = lane >> 5;
    const long qrow = kbase + (long)(qs0 + r32) * kstride;
    bf16x8 qr[4];
#pragma unroll
    for (int d0 = 0; d0 < 4; ++d0) qr[d0] = *(const bf16x8*)(QKV + qrow * QKVW + colq + 16 * d0 + 8 * hi);
    const bf16_t* kcol = QKV + colq + 256 + 8 * hi;
    const bf16_t* vcol = QKV + colq + 512 + (lane & 7) * 8;
    const int vwoff = ((lane & 7) >> 2) * 2048 + ((lane & 7) & 3) * 16;
    const int vroff = ((lane >> 4) & 1) * 32 + (lane & 3) * 8 + (4 * hi + ((lane & 15) >> 2)) * 64;
    bf16x8 kf[4]; u32x4 vr[4];
    {
        const long kr = kbase + (long)(32 * tlo + r32) * kstride;
#pragma unroll
        for (int d0 = 0; d0 < 4; ++d0) kf[d0] = *(const bf16x8*)(kcol + kr * QKVW + 16 * d0);
#pragma unroll
        for (int i = 0; i < 4; ++i) { const long vrw = kbase + (long)(32 * tlo + i * 8 + (lane >> 3)) * kstride; vr[i] = *(const u32x4*)(vcol + vrw * QKVW); }
    }
    f32x16 o0 = {}, o1 = {}; float m_run = -1e30f, l_run = 0.f;
    for (int T = tlo; T <= thi; ++T) {
        LAS unsigned char* vbuf = vb + ((T & 1) ? 4096 : 0);
#pragma unroll
        for (int i = 0; i < 4; ++i) { const int row = i * 8 + (lane >> 3); *(LAS u32x4*)(vbuf + vwoff + (row >> 4) * 1024 + (row & 15) * 64) = vr[i]; }
        bf16x8 kn[4]; u32x4 vn[4];
        const int Tn = (T < thi) ? T + 1 : T;
        {
            const long kr = kbase + (long)(32 * Tn + r32) * kstride;
#pragma unroll
            for (int d0 = 0; d0 < 4; ++d0) kn[d0] = *(const bf16x8*)(kcol + kr * QKVW + 16 * d0);
#pragma unroll
            for (int i = 0; i < 4; ++i) { const long vrw = kbase + (long)(32 * Tn + i * 8 + (lane >> 3)) * kstride; vn[i] = *(const u32x4*)(vcol + vrw * QKVW); }
        }
        f32x16 p = {};
#pragma unroll
        for (int d0 = 0; d0 < 4; ++d0) p = __builtin_amdgcn_mfma_f32_32x32x16_bf16(kf[d0], qr[d0], p, 0, 0, 0);
        if (T == tlo || T == thi) {
            const int qs = qs0 + r32;
#pragma unroll
            for (int r = 0; r < 16; ++r) { const int ks = 32 * T + crow(r, hi); if (ks > qs || ks < qs - 128) p[r] = -1e30f; }
        }
        float rm = p[0];
#pragma unroll
        for (int r = 1; r < 16; ++r) rm = fmaxf(rm, p[r]);
        rm = swapmax(rm);
        const float mn = fmaxf(m_run, rm), alpha = __builtin_amdgcn_exp2f(m_run - mn); m_run = mn;
        float ls = 0.f;
#pragma unroll
        for (int r = 0; r < 16; ++r) { p[r] = __builtin_amdgcn_exp2f(p[r] - mn); ls += p[r]; }
        l_run = l_run * alpha + ls;
#pragma unroll
        for (int r = 0; r < 16; ++r) { o0[r] *= alpha; o1[r] *= alpha; }
        u32x4 pw0, pw1;
        pw0.x = cvt_pk_bf16(p[0], p[1]); pw0.y = cvt_pk_bf16(p[2], p[3]); pw0.z = cvt_pk_bf16(p[4], p[5]); pw0.w = cvt_pk_bf16(p[6], p[7]);
        pw1.x = cvt_pk_bf16(p[8], p[9]); pw1.y = cvt_pk_bf16(p[10], p[11]); pw1.z = cvt_pk_bf16(p[12], p[13]); pw1.w = cvt_pk_bf16(p[14], p[15]);
        const LAS unsigned char* vp = vbuf + vroff;
#define VFRAG(d0, s) ({ const s16x4 lo_ = vtr(vp + (d0) * 2048 + (s) * 1024), hi_ = vtr(vp + (d0) * 2048 + (s) * 1024 + 512); \
            (bf16x8){lo_[0], lo_[1], lo_[2], lo_[3], hi_[0], hi_[1], hi_[2], hi_[3]}; })
        o0 = __builtin_amdgcn_mfma_f32_32x32x16_bf16(VFRAG(0, 0), __builtin_bit_cast(bf16x8, pw0), o0, 0, 0, 0);
        o0 = __builtin_amdgcn_mfma_f32_32x32x16_bf16(VFRAG(0, 1), __builtin_bit_cast(bf16x8, pw1), o0, 0, 0, 0);
        o1 = __builtin_amdgcn_mfma_f32_32x32x16_bf16(VFRAG(1, 0), __builtin_bit_cast(bf16x8, pw0), o1, 0, 0, 0);
        o1 = __builtin_amdgcn_mfma_f32_32x32x16_bf16(VFRAG(1, 1), __builtin_bit_cast(bf16x8, pw1), o1, 0, 0, 0);
#undef VFRAG
#pragma unroll
        for (int d0 = 0; d0 < 4; ++d0) kf[d0] = kn[d0];
#pragma unroll
        for (int i = 0; i < 4; ++i) vr[i] = vn[i];
    }
    const float lt = swapsum(l_run), il = 1.0f / lt;
    bf16_t* op = OGp + qrow * 768;
#pragma unroll
    for (int a4 = 0; a4 < 4; ++a4) {
        u32x2 w0, w1;
        w0.x = cvt_pk_bf16(o0[4 * a4] * il, o0[4 * a4 + 1] * il); w0.y = cvt_pk_bf16(o0[4 * a4 + 2] * il, o0[4 * a4 + 3] * il);
        w1.x = cvt_pk_bf16(o1[4 * a4] * il, o1[4 * a4 + 1] * il); w1.y = cvt_pk_bf16(o1[4 * a4 + 2] * il, o1[4 * a4 + 3] * il);
        *(u32x2*)(op + 8 * a4 + 4 * hi) = w0; *(u32x2*)(op + 32 + 8 * a4 + 4 * hi) = w1;
    }
    if (hi == 0) LSEp[qrow * 12] = m_run + __builtin_amdgcn_logf(lt);
}

__device__ __forceinline__ void sample_task(const bf16_t* QKV, const float* cache, int W, int dil, int n, int h, int g, LAS float* sc, bf16_t* OG, float* LSE, int lane) {
    const long row = MP + n; const bf16_t* qp = QKV + row * QKVW + g * 768 + h * 64;
    const int dch = lane & 15, jl = lane >> 4;
    f32x4 q4; { const u32x2 w = *(const u32x2*)(qp + 4 * dch); q4 = (f32x4){bflo(w.x), bfhi(w.x), bflo(w.y), bfhi(w.y)}; }
    for (int it = 0; it < 33; ++it) {
        const int j = 4 * it + jl; f32x4 k4 = {0.f, 0.f, 0.f, 0.f};
        if (j == 0) { const u32x2 w = *(const u32x2*)(qp + 256 + 4 * dch); k4 = (f32x4){bflo(w.x), bfhi(w.x), bflo(w.y), bfhi(w.y)}; }
        else if (j <= 128) k4 = *(const f32x4*)(cache + ((size_t)(n * W + (W - dil * j)) * 2 + 0) * 256 + h * 64 + 4 * dch);
        float s = (k4[0] * q4[0] + k4[1] * q4[1]) + (k4[2] * q4[2] + k4[3] * q4[3]);
        s += __shfl_xor(s, 1); s += __shfl_xor(s, 2); s += __shfl_xor(s, 4); s += __shfl_xor(s, 8);
        if (dch == 0) sc[j] = (j <= 128) ? s : -1e30f;
    }
    LDS_WAIT(); asm volatile("" ::: "memory");
    float s0 = sc[lane], s1 = sc[lane + 64], s2 = (lane < 4) ? sc[lane + 128] : -1e30f;
    float mx = fmaxf(fmaxf(s0, s1), s2);
#pragma unroll
    for (int o = 1; o < 64; o <<= 1) mx = fmaxf(mx, __shfl_xor(mx, o));
    const float p0 = __builtin_amdgcn_exp2f(s0 - mx), p1 = __builtin_amdgcn_exp2f(s1 - mx), p2 = __builtin_amdgcn_exp2f(s2 - mx);
    const float l = wave_sum(p0 + p1 + p2);
    LDS_WAIT(); asm volatile("" ::: "memory");
    sc[lane] = p0; sc[lane + 64] = p1; if (lane < 4) sc[lane + 128] = p2;
    LDS_WAIT(); asm volatile("" ::: "memory");
    f32x4 ac = {0.f, 0.f, 0.f, 0.f};
    for (int it = 0; it < 33; ++it) {
        const int j = 4 * it + jl; f32x4 v4 = {0.f, 0.f, 0.f, 0.f}; const float pj = sc[j];
        if (j == 0) { const u32x2 w = *(const u32x2*)(qp + 512 + 4 * dch); v4 = (f32x4){bflo(w.x), bfhi(w.x), bflo(w.y), bfhi(w.y)}; }
        else if (j <= 128) v4 = *(const f32x4*)(cache + ((size_t)(n * W + (W - dil * j)) * 2 + 1) * 256 + h * 64 + 4 * dch);
        ac += v4 * pj;
    }
#pragma unroll
    for (int e = 0; e < 4; ++e) { ac[e] += __shfl_xor(ac[e], 16); ac[e] += __shfl_xor(ac[e], 32); }
    const float il = 1.0f / l;
    if (lane < 16) *(u32x2*)(OG + row * 768 + g * 256 + h * 64 + 4 * dch) = pack4(ac * il);
    if (lane == 0) LSE[row * 12 + g * 4 + h] = mx + __builtin_amdgcn_logf(l);
    LDS_WAIT(); asm volatile("" ::: "memory");
}

__device__ __forceinline__ void merge_row(const bf16_t* OG, const float* LSE, bf16_t* ATT, long row, int h, int ch) {
    const float l0 = LSE[row * 12 + h], l1 = LSE[row * 12 + 4 + h], l2 = LSE[row * 12 + 8 + h];
    const float mx = fmaxf(fmaxf(l0, l1), l2);
    float w0 = __builtin_amdgcn_exp2f(l0 - mx), w1 = __builtin_amdgcn_exp2f(l1 - mx), w2 = __builtin_amdgcn_exp2f(l2 - mx);
    const float inv = 1.0f / (w0 + w1 + w2); w0 *= inv; w1 *= inv; w2 *= inv;
    const bf16_t* p = OG + row * 768 + h * 64 + 8 * ch;
    const u32x4 a = *(const u32x4*)p, b = *(const u32x4*)(p + 256), c = *(const u32x4*)(p + 512);
    u32x4 o;
    o.x = cvt_pk_bf16(w0 * bflo(a.x) + w1 * bflo(b.x) + w2 * bflo(c.x), w0 * bfhi(a.x) + w1 * bfhi(b.x) + w2 * bfhi(c.x));
    o.y = cvt_pk_bf16(w0 * bflo(a.y) + w1 * bflo(b.y) + w2 * bflo(c.y), w0 * bfhi(a.y) + w1 * bfhi(b.y) + w2 * bfhi(c.y));
    o.z = cvt_pk_bf16(w0 * bflo(a.z) + w1 * bflo(b.z) + w2 * bflo(c.z), w0 * bfhi(a.z) + w1 * bfhi(b.z) + w2 * bfhi(c.z));
    o.w = cvt_pk_bf16(w0 * bflo(a.w) + w1 * bflo(b.w) + w2 * bflo(c.w), w0 * bfhi(a.w) + w1 * bfhi(b.w) + w2 * bfhi(c.w));
    *(u32x4*)(ATT + row * AW + h * 64 + 8 * ch) = o;
}
}

__device__ __forceinline__ void p4_mixers(const Frame& F, const Args& a) {
    unsigned char* ws = a.ws;
    const bf16_t* QKV = (const bf16_t*)(ws + WS_QKV); const bf16_t* U = (const bf16_t*)(ws + WS_U);
    bf16_t* OG = (bf16_t*)(ws + WS_OG); float* LSE = (float*)(ws + WS_LSE); bf16_t* ATT = (bf16_t*)(ws + WS_ATT); bf16_t* P = (bf16_t*)(ws + WS_P);
    const int lane = F.lane, wv = F.wave;
    for (int unit = F.vcu; unit < 256; unit += F.G) {
        const int b = unit >> 4, h = (unit >> 2) & 3, blk = unit & 3;
        if (unit < 128 && wv < 3) {
            const int n = unit >> 2, hh = unit & 3;
            const float* cache = (wv == 0) ? a.in[3] : (wv == 1) ? a.in[4] : a.in[5];
            att::sample_task(QKV, cache, 128 << (2 * wv), 1 << (2 * wv), n, hh, wv, (LAS float*)(F.lds + 65536 + wv * 1024), OG, LSE, lane);
        }
        LAS unsigned char* vb = F.lds + wv * 8192;
        const long tok0 = (long)b * SEQ;
#pragma unroll 1
        for (int g = 0; g < 3; ++g) {
            const int dil = 1 << (2 * g), ns = 512 / dil;
#pragma unroll 1
            for (int sub = 0; sub < 2; ++sub) {
                const int f = (2 * wv + sub) * 32;
                const int rho = f / ns, sl = f - rho * ns;
                const int qs0 = blk * ns + sl;
                const int tlo = (qs0 >= 128) ? (qs0 - 128) / 32 : 0, thi = qs0 / 32;
                att::task(QKV, g * 768 + h * 64, tok0 + rho, dil, qs0, tlo, thi, vb, OG + g * 256 + h * 64, LSE + g * 4 + h, lane);
            }
        }
        {
            const int gi = h, w = 2 << gi, ch = F.tid & 15, rg = F.tid >> 4, t0 = blk * 512 + rg * 16;
            const bf16_t* up = U + (size_t)tok0 * PW + gi * 128 + ch * 8; bf16_t* pp = P + (size_t)tok0 * PW + gi * 128 + ch * 8;
            float S[8] = {0.f, 0.f, 0.f, 0.f, 0.f, 0.f, 0.f, 0.f};
            for (int i = 1; i < w; ++i) { const int t = t0 - i; if (t >= 0) { const u32x4 x = *(const u32x4*)(up + (size_t)t * PW);
                S[0] += bflo(x.x); S[1] += bfhi(x.x); S[2] += bflo(x.y); S[3] += bfhi(x.y); S[4] += bflo(x.z); S[5] += bfhi(x.z); S[6] += bflo(x.w); S[7] += bfhi(x.w); } }
#pragma unroll 4
            for (int i = 0; i < 16; ++i) { const int t = t0 + i; const u32x4 x = *(const u32x4*)(up + (size_t)t * PW);
                const float xv[8] = {bflo(x.x), bfhi(x.x), bflo(x.y), bfhi(x.y), bflo(x.z), bfhi(x.z), bflo(x.w), bfhi(x.w)};
                const float ic = 1.0f / (float)((t + 1 < w) ? t + 1 : w); float pv[8];
#pragma unroll
                for (int e = 0; e < 8; ++e) { S[e] += xv[e]; pv[e] = S[e] * ic - xv[e]; }
                u32x4 o; o.x = cvt_pk_bf16(pv[0], pv[1]); o.y = cvt_pk_bf16(pv[2], pv[3]); o.z = cvt_pk_bf16(pv[4], pv[5]); o.w = cvt_pk_bf16(pv[6], pv[7]);
                *(u32x4*)(pp + (size_t)t * PW) = o;
                const int tb = t - w + 1; if (tb >= 0) { const u32x4 y = *(const u32x4*)(up + (size_t)tb * PW);
                    S[0] -= bflo(y.x); S[1] -= bfhi(y.x); S[2] -= bflo(y.y); S[3] -= bfhi(y.y); S[4] -= bflo(y.z); S[5] -= bfhi(y.z); S[6] -= bflo(y.w); S[7] -= bfhi(y.w); } }
        }
        if (unit >= 128 && unit < 160) {
            const int n = unit - 128, c = F.tid, gi = c >> 7, w = 2 << gi;
            const float un = bf2f(U[(size_t)(MP + n) * PW + c]); float S = un; const float* sp = a.in[2] + (size_t)n * 15 * PW + c;
            for (int i = 1; i < w; ++i) S += sp[(size_t)(15 - i) * PW];
            const float pv = S / (float)w - un;
            P[(size_t)(MP + n) * PW + c] = (bf16_t)(cvt_pk_bf16(pv, 0.f) & 0xffffu);
        }
        asm volatile("s_waitcnt vmcnt(0)" ::: "memory");
        __syncthreads();
        { const int rl = F.tid >> 3, ch = F.tid & 7;
#pragma unroll 2
            for (int it = 0; it < 8; ++it) att::merge_row(OG, LSE, ATT, tok0 + blk * 512 + it * 64 + rl, h, ch);
            if (unit < 128 && F.tid < 8) att::merge_row(OG, LSE, ATT, MP + (unit >> 2), unit & 3, F.tid);
        }
        __syncthreads();
    }
}

__device__ __forceinline__ void p9_final(const Frame& F, const Args& a) {
    const float* ss3 = (const float*)(a.ws + WS_SSP) + 2 * SSP_STRIDE; const f32x4* g4 = (const f32x4*)a.in[21] + F.lane;
    const int gw = F.vcu * NWAVES + F.wave, NGW = F.G * NWAVES;
    f32x4 gv[4];
#pragma unroll
    for (int j = 0; j < 4; ++j) gv[j] = g4[64 * j];
    for (int m = gw; m < MP + NS; m += NGW) {
        const float* src = (m < MP) ? a.out + O_YP + (size_t)m * DM : (const float*)(a.ws + WS_XS) + (size_t)(m - MP) * DM;
        float* dst = (m < MP) ? a.out + O_YP + (size_t)m * DM : a.out + O_YS + (size_t)(m - MP) * DM;
        const float rs = 1.0f / sqrtf(wave_sum(F.lane < 16 ? ss3[(size_t)F.lane * MT + m] : 0.f) * (1.0f / DM) + RMS_EPS);
        const f32x4* s4 = (const f32x4*)src + F.lane; f32x4* d4 = (f32x4*)dst + F.lane;
        f32x4 v[4];
#pragma unroll
        for (int j = 0; j < 4; ++j) v[j] = s4[64 * j];
#pragma unroll
        for (int j = 0; j < 4; ++j) d4[64 * j] = v[j] * rs * gv[j];
    }
}

constexpr int N_PHASES = 10;
__global__ void __launch_bounds__(NWAVES * 64, 2) hybrid_fwd(Args args) {
    extern __shared__ __attribute__((aligned(16))) unsigned char lds[];
    Frame F;
    F.lds = (LAS unsigned char*)lds;
    F.tid = threadIdx.x; F.lane = F.tid & 63; F.wave = __builtin_amdgcn_readfirstlane(F.tid >> 6);
    F.G = gridDim.x; { const int bx = blockIdx.x; F.vcu = (F.G % 8 == 0) ? (bx % 8) * (F.G / 8) + bx / 8 : bx; }
    unsigned char* ws = args.ws;
    gu32* ctl = (gu32*)(ws + WS_CTL);
    for (int u = F.tid; u < (LDS_BYTES - LDSCTL_OFF) / 4; u += NWAVES * 64) ((LAS unsigned*)(F.lds + LDSCTL_OFF))[u] = 0u;
    __syncthreads();
    XcdBarrier bar; bar.bar = (unsigned*)(ctl + CW_BAR); bar.x = 0; bar.st = nullptr;
    const int lo = args.ph_lo, hi = args.ph_hi;
    if (hi - lo > 1) bar = xcd_barrier_post((unsigned*)(ctl + CW_BAR), (volatile LAS unsigned*)(F.lds + MISC_OFF) + 8);
#define IN(k) (lo <= (k) && (k) < hi)
#define SEAM(k) do { if (IN(k) && IN((k) + 1)) xcd_barrier(bar); } while (0)
    float* ss0 = (float*)(ws + WS_CTL) + CW_SS; float* ssp = (float*)(ws + WS_SSP);
    bf16_t* XB = (bf16_t*)(ws + WS_XB); bf16_t* H = (bf16_t*)(ws + WS_H); float* XS = (float*)(ws + WS_XS);
    float* XRES = args.out + O_YP;

    if (IN(0)) { p0_prologue(F, args); } SEAM(0);
#ifdef DIAG_DUMP_W
    if (IN(0) && !IN(1)) { xcd_barrier(bar);
        const size_t gt = (size_t)F.vcu * 512 + F.tid, NT = (size_t)F.G * 512; const bf16_t* Wd = (const bf16_t*)(ws + WS_W1UP); float* y = args.out + O_YP;
        for (size_t i = gt; i < (WS_XS - WS_W1UP) / 2; i += NT) y[i] = bf2f(Wd[i]); }
#endif

    if (IN(1)) {
        pg8::Gemm g{XB, (const bf16_t*)(ws + WS_W1UP), MT, 2 * FF, DM, (size_t)128 * DM, (size_t)FF * DM}; pg8::StaticOrder S; S.init(MT, 2 * FF, F.G, (int)blockIdx.x);
        EpiUp<1> E{H, ss0};
        pg8::gemm_phase<EpiUp<1>, pg8::StaticOrder, true, true>(F.lds + RING_OFF, g, S, E);
    } SEAM(1);
    if (IN(2)) {
        pg8::Gemm g{H, (const bf16_t*)(ws + WS_W1DN), MT, DM, FF, (size_t)256 * FF, (size_t)128 * FF}; pg8::StaticOrder S; S.init(MT, DM, F.G, (int)blockIdx.x);
        EpiRes E{args.in[0], XRES, XS, XB, ssp, 0.5f};
        pg8::gemm_phase<EpiRes, pg8::StaticOrder, true, true>(F.lds + RING_OFF, g, S, E);
    } SEAM(2);
    if (IN(3)) {
        pg8::Gemm g{XB, (const bf16_t*)(ws + WS_WIN), MT, INW, DM, (size_t)256 * DM, (size_t)128 * DM}; pg8::StaticOrder S; S.init(MT, INW, F.G, (int)blockIdx.x);
        EpiIn E{ssp, (bf16_t*)(ws + WS_U), (bf16_t*)(ws + WS_QKV), (bf16_t*)(ws + WS_G), args.out};
        pg8::gemm_phase<EpiIn, pg8::StaticOrder, true, true>(F.lds + RING_OFF, g, S, E);
    } SEAM(3);
    if (IN(4)) { p4_mixers(F, args); } SEAM(4);
#ifdef DIAG_DUMP_P4
    if (IN(4) && !IN(5)) { xcd_barrier(bar);
        const size_t gt = (size_t)F.vcu * 512 + F.tid, NT = (size_t)F.G * 512; const bf16_t* ATTd = (const bf16_t*)(ws + WS_ATT); const bf16_t* Pd = (const bf16_t*)(ws + WS_P); float* y = args.out + O_YP;
        for (size_t i = gt; i < (size_t)(MP + NS) * AW; i += NT) y[i] = bf2f(ATTd[i]);
        for (size_t i = gt; i < (size_t)(MP + NS) * PW; i += NT) y[(size_t)(MP + NS) * AW + i] = bf2f(Pd[i]); }
#endif
    if (IN(5)) {
        { pg8::Gemm g{(const bf16_t*)(ws + WS_P), (const bf16_t*)(ws + WS_WCOMB), MT, DM, PW, (size_t)256 * PW, (size_t)128 * PW}; pg8::StaticOrder S; S.init(MT, DM, F.G, (int)blockIdx.x);
          EpiBr<0> E{(const bf16_t*)(ws + WS_G), (bf16_t*)(ws + WS_T1), (bf16_t*)(ws + WS_MG)};
          pg8::gemm_phase<EpiBr<0>, pg8::StaticOrder, true, true>(F.lds + RING_OFF, g, S, E); }
        asm volatile("s_waitcnt vmcnt(0)" ::: "memory"); __syncthreads();
        { pg8::Gemm g{(const bf16_t*)(ws + WS_ATT), (const bf16_t*)(ws + WS_WAB), MT, DM, AW, (size_t)256 * AW, (size_t)128 * AW}; pg8::StaticOrder S; S.init(MT, DM, F.G, (int)blockIdx.x);
          EpiBr<1> E{(const bf16_t*)(ws + WS_G), (bf16_t*)(ws + WS_T1), (bf16_t*)(ws + WS_MG)};
          pg8::gemm_phase<EpiBr<1>, pg8::StaticOrder, true, true>(F.lds + RING_OFF, g, S, E); }
    } SEAM(5);
#ifdef DIAG_DUMP
    if (IN(DIAG_STOP - 1) && !IN(DIAG_STOP)) { xcd_barrier(bar);
        const size_t gt = (size_t)F.vcu * 512 + F.tid, NT = (size_t)F.G * 512; const bf16_t* MGd = (const bf16_t*)(ws + DIAG_DUMP_OFF); float* y = args.out + O_YP;
        for (size_t i = gt; i < (size_t)MP * DM; i += NT) y[i] = bf2f(MGd[i]); }
#endif
    if (IN(6)) {
        pg8::Gemm g{(const bf16_t*)(ws + WS_MG), (const bf16_t*)(ws + WS_WO), MT, DM, DM, (size_t)256 * DM, (size_t)128 * DM}; pg8::StaticOrder S; S.init(MT, DM, F.G, (int)blockIdx.x);
        EpiRes E{XRES, XRES, XS, XB, ssp + SSP_STRIDE, 1.0f};
        pg8::gemm_phase<EpiRes, pg8::StaticOrder, true, true>(F.lds + RING_OFF, g, S, E);
    } SEAM(6);
    if (IN(7)) {
        pg8::Gemm g{XB, (const bf16_t*)(ws + WS_W2UP), MT, 2 * FF, DM, (size_t)128 * DM, (size_t)FF * DM}; pg8::StaticOrder S; S.init(MT, 2 * FF, F.G, (int)blockIdx.x);
        EpiUp<16> E{H, ssp + SSP_STRIDE};
        pg8::gemm_phase<EpiUp<16>, pg8::StaticOrder, true, true>(F.lds + RING_OFF, g, S, E);
    } SEAM(7);
    if (IN(8)) {
        pg8::Gemm g{H, (const bf16_t*)(ws + WS_W2DN), MT, DM, FF, (size_t)256 * FF, (size_t)128 * FF}; pg8::StaticOrder S; S.init(MT, DM, F.G, (int)blockIdx.x);
        EpiRes E{XRES, XRES, XS, nullptr, ssp + 2 * SSP_STRIDE, 0.5f};
        pg8::gemm_phase<EpiRes, pg8::StaticOrder, true, true>(F.lds + RING_OFF, g, S, E);
    } SEAM(8);
    if (IN(9)) { p9_final(F, args); }
#undef IN
#undef SEAM
}

extern "C" void kernel_launch(void* const* d_in, const int* in_sizes, int n_in, void* d_out, int out_size, void* d_ws, size_t ws_size, hipStream_t stream) {
    static int grid = 0;
    if (grid == 0) {
        if (n_in != 22 || in_sizes[0] != MP * DM || (size_t)out_size != O_END || ws_size < WS_END) {
            fprintf(stderr, "kernel_launch: unexpected shapes (n_in %d, in0 %d, out %d, ws %zu need %zu); nothing launched\n", n_in, n_in > 0 ? in_sizes[0] : -1, out_size, ws_size, (size_t)WS_END); grid = -1; return; }
        int dev = 0, cus = 0, per_cu = 0;
        if (hipGetDevice(&dev) != hipSuccess || hipDeviceGetAttribute(&cus, hipDeviceAttributeMultiprocessorCount, dev) != hipSuccess) { grid = -1; return; }
        if (hipFuncSetAttribute((const void*)hybrid_fwd, hipFuncAttributeMaxDynamicSharedMemorySize, LDS_BYTES) != hipSuccess) { fprintf(stderr, "kernel_launch: hipFuncSetAttribute failed\n"); grid = -1; return; }
        if (hipOccupancyMaxActiveBlocksPerMultiprocessor(&per_cu, (const void*)hybrid_fwd, NWAVES * 64, LDS_BYTES) != hipSuccess || per_cu < 1) {
            fprintf(stderr, "kernel_launch: occupancy query reports %d workgroups per CU\n", per_cu); per_cu = 1; }
        (void)hipGetLastError();
        grid = cus;
    }
    if (grid < 0) return;
#ifdef DIAG_POISON
    (void)hipMemsetAsync((char*)d_ws, 0xAA, WS_END, stream); (void)hipMemsetAsync((char*)d_out, 0xAA, O_END * 4, stream);
#endif
    if (hipMemsetAsync((char*)d_ws + WS_CTL, 0, CTL_ZERO_BYTES, stream) != hipSuccess) { fprintf(stderr, "kernel_launch: memset failed\n"); return; }
    Args a{};
    for (int i = 0; i < 22; ++i) a.in[i] = (const float*)d_in[i];
    a.out = (float*)d_out; a.ws = (unsigned char*)d_ws;
    constexpr int NL = MK_N_LAUNCHES;
    for (int li = 0; li < NL; ++li) {
        a.ph_lo = (NL == 1) ? 0 : li; a.ph_hi = (NL == 1) ? N_PHASES : li + 1;
#ifdef DIAG_STOP
        a.ph_hi = DIAG_STOP;
#endif
        hipLaunchKernelGGL(hybrid_fwd, dim3(grid), dim3(NWAVES * 64), LDS_BYTES, stream, a);
        const hipError_t le = hipPeekAtLastError();
        if (le != hipSuccess) { fprintf(stderr, "kernel_launch: launch %d failed: %s\n", li, hipGetErrorName(le)); break; }
    }
}
```

```cpp
#include <hip/hip_runtime.h>
#include <cstdio>
#include <cstdint>

#ifndef MK_N_LAUNCHES
#define MK_N_LAUNCHES 1
#endif

constexpr int DM = 1024, NB = 16, SEQ = 2048, NS = 32, PAST = 16384, FF = 2816, INW = 4864;
constexpr int MP = NB * SEQ;
constexpr int MT = MP + 256;
constexpr int QKVW = 2304, PW = 512, GW = 2048, AW = 256;
constexpr float RMS_EPS = 1e-6f;
constexpr float C2 = 0.125f * 1.4426950408889634f;

constexpr size_t O_YP = 0, O_YS = 33554432, O_POOLP = 33587200, O_KV128P = 33710080, O_KV512P = 34758656, O_KV2048P = 38952960,
                 O_POOLS = 55730176, O_KV128S = 55975936, O_KV512S = 58073088, O_KV2048S = 66461696, O_END = 100016128;

namespace pg8 {
#define PG8_LAS __attribute__((address_space(3)))
typedef unsigned short bf16_t;
typedef short bf16x8 __attribute__((ext_vector_type(8)));
typedef float f32x4 __attribute__((ext_vector_type(4)));
typedef float f32x2 __attribute__((ext_vector_type(2)));
typedef unsigned u32x4 __attribute__((ext_vector_type(4)));
typedef unsigned u32x2 __attribute__((ext_vector_type(2)));
constexpr int BM = 256, BK = 64, HALF = 128, HTB = HALF * BK * 2, STAGE_BYTES = 8 * HTB, NXCD = 8, WGM = 8;

__host__ __device__ __forceinline__ int lds_byte(int r, int c) { const int st = (r >> 4) * 2 + (c >> 5), rr = r & 15, cc = c & 31, ob = rr * 64 + cc * 2; return st * 1024 + (ob ^ (((ob >> 9) & 1) << 5)); }
__host__ __device__ __forceinline__ void stage_rc(int b, int& R, int& C) { const int st = b / 1024, sb = b % 1024, swz = sb ^ (((sb >> 9) & 1) << 5); R = (st >> 1) * 16 + swz / 64; C = (st & 1) * 32 + (swz % 64) / 2; }
__host__ __device__ __forceinline__ int perm32(int rho) { const int n = rho >> 4, i = rho & 15; return 8 * (i >> 2) + 4 * n + (i & 3); }

struct Unit { int pm, pn; };
struct Gemm { const bf16_t* A; const bf16_t* Bt; int M, N, K; size_t b_tile, b_half; };

struct StaticOrder {
    int nM, nN, nwg, G, c;
    __host__ __device__ void init(int M, int N, int G_, int c_) { nM = M / BM; nN = N / BM; nwg = nM * nN; G = G_; c = c_; }
    __host__ __device__ bool next(int i, Unit& u) const {
        const long L = (long)i * G + c; if (L >= nwg) return false;
        int wgid = (int)L; { const int q = nwg / NXCD, r = nwg % NXCD, xcd = wgid % NXCD, off = wgid / NXCD; wgid = (xcd < r ? xcd * (q + 1) : r * (q + 1) + (xcd - r) * q) + off; }
        const int nig = WGM * nN, gid = wgid / nig, fm = gid * WGM, gsz = (nM - fm) < WGM ? (nM - fm) : WGM;
        u.pm = fm + ((wgid % nig) % gsz); u.pn = (wgid % nig) / gsz; return true;
    }
};

typedef __bf16 bf16x2_t __attribute__((ext_vector_type(2)));
__device__ __forceinline__ unsigned cvt_pk_bf16(float lo, float hi) { const f32x2 v = {lo, hi}; const bf16x2_t b = __builtin_convertvector(v, bf16x2_t); return __builtin_bit_cast(unsigned, b); }

template <class Epi, class Sched, bool ALIGN_EPI = false, bool SP2 = false>
__device__ __forceinline__ void gemm_phase(PG8_LAS unsigned char* lds, const Gemm g, const Sched& S, const Epi& E) {
    const int tid = threadIdx.x, wid = __builtin_amdgcn_readfirstlane(tid >> 6), lane = tid & 63, wr = wid >> 2, wc = wid & 3, fr = lane & 15, fq = lane >> 4;
    const int K = g.K, nt = K / BK;
    unsigned voffA[2], voffB[2];
#pragma unroll
    for (int i = 0; i < 2; ++i) { int R, C; stage_rc(tid * 16 + i * 8192, R, C); int Rb = R;
        if constexpr (Epi::PERM == 1) Rb = (R & ~31) + perm32(R & 31);
        if constexpr (Epi::PERM == 2) Rb = (R & ~48) | (((R >> 4) & 1) << 5) | (((R >> 5) & 1) << 4);
        voffA[i] = (unsigned)(R * K + C) * 2u; voffB[i] = (unsigned)(Rb * K + C) * 2u; }
    const size_t kstep = (size_t)(BK * 2);
    const size_t hstep = (size_t)HALF * K * 2;
    const size_t tstep = 2 * hstep;
    const size_t bhstep = g.b_half * 2, btstep = g.b_tile * 2;
    const unsigned ldsw = (unsigned)wid * 1024u;
    const int aoff = lds_byte(wr * 64 + fr, fq * 8), boff = lds_byte(wc * 32 + fr, fq * 8);
#define PG8_SA(b, h) (((b) * 2 + (h)) * HTB)
#define PG8_SB(b, h) ((4 + (b) * 2 + (h)) * HTB)
#define PG8_STAGE(bufoff, gbase, voff) do { _Pragma("unroll") for (int _i = 0; _i < 2; ++_i) \
        __builtin_amdgcn_global_load_lds((const unsigned*)((const char*)(gbase) + (voff)[_i]), (PG8_LAS unsigned*)(lds + (bufoff) + ldsw + _i * 8192), 16, 0, 0); } while (0)
#define PG8_LDA(dst, b, h) do { _Pragma("unroll") for (int m = 0; m < 4; ++m) _Pragma("unroll") for (int k = 0; k < 2; ++k) dst[m][k] = *(const PG8_LAS bf16x8*)(lds + PG8_SA(b, h) + aoff + m * 2048 + k * 1024); } while (0)
#define PG8_LDB(dst, b, h) do { _Pragma("unroll") for (int n = 0; n < 2; ++n) _Pragma("unroll") for (int k = 0; k < 2; ++k) dst[n][k] = *(const PG8_LAS bf16x8*)(lds + PG8_SB(b, h) + boff + n * 2048 + k * 1024); } while (0)
#define PG8_MMA(ai, bj, At, Bt) do { __builtin_amdgcn_s_setprio(1); _Pragma("unroll") for (int m = 0; m < 4; ++m) _Pragma("unroll") for (int n = 0; n < 2; ++n) _Pragma("unroll") for (int k = 0; k < 2; ++k) \
        acc[ai][bj][m][n] = __builtin_amdgcn_mfma_f32_16x16x32_bf16(Bt[n][k], At[m][k], acc[ai][bj][m][n], 0, 0, 0); __builtin_amdgcn_s_setprio(0); } while (0)
#define PG8_WAIT_V(n) asm volatile("s_waitcnt vmcnt(" #n ")" ::: "memory")
#define PG8_WAIT_L(n) asm volatile("s_waitcnt lgkmcnt(" #n ")" ::: "memory")
#define PG8_BAR __builtin_amdgcn_s_barrier()
#define PG8_SCHED __builtin_amdgcn_sched_barrier(0)
    Unit cur, nxt; int ui = 0;
    if (!S.next(0, cur)) return;
    f32x4 acc[2][2][4][2];
#pragma unroll
    for (int a = 0; a < 2; ++a)
#pragma unroll
        for (int b = 0; b < 2; ++b)
#pragma unroll
            for (int m = 0; m < 4; ++m)
#pragma unroll
                for (int n = 0; n < 2; ++n) acc[a][b][m][n] = (f32x4){0.f, 0.f, 0.f, 0.f};
    bf16x8 At[4][2], B0[2][2], B1[2][2];
    const char* cA = (const char*)g.A + (size_t)cur.pm * tstep; const char* cB = (const char*)g.Bt + (size_t)cur.pn * btstep;
    if constexpr (SP2) {
        PG8_STAGE(PG8_SB(0, 0), cB, voffB); PG8_STAGE(PG8_SB(0, 1), cB + bhstep, voffB); PG8_STAGE(PG8_SA(0, 0), cA, voffA); PG8_STAGE(PG8_SA(0, 1), cA + hstep, voffA);
        if (wr == 1) PG8_BAR;
        PG8_WAIT_V(2); PG8_BAR;
        PG8_STAGE(PG8_SB(1, 0), cB + kstep, voffB); PG8_STAGE(PG8_SA(1, 0), cA + kstep, voffA); PG8_STAGE(PG8_SB(1, 1), cB + bhstep + kstep, voffB);
        PG8_WAIT_V(6); PG8_BAR;
    } else {
        PG8_STAGE(PG8_SB(0, 0), cB, voffB); PG8_STAGE(PG8_SA(0, 0), cA, voffA); PG8_STAGE(PG8_SB(0, 1), cB + bhstep, voffB); PG8_STAGE(PG8_SA(0, 1), cA + hstep, voffA);
        if (wr == 1) PG8_BAR;
        PG8_WAIT_V(4); PG8_BAR;
        PG8_STAGE(PG8_SB(1, 0), cB + kstep, voffB); PG8_STAGE(PG8_SA(1, 0), cA + kstep, voffA); PG8_STAGE(PG8_SB(1, 1), cB + bhstep + kstep, voffB);
        PG8_WAIT_V(6); PG8_BAR;
    }
    for (;;) {
        const bool has_next = S.next(ui + 1, nxt);
        const char* nA = has_next ? (const char*)g.A + (size_t)nxt.pm * tstep : cA; const char* nB = has_next ? (const char*)g.Bt + (size_t)nxt.pn * btstep : cB;
        for (int t = 0; t < nt; t += 2) {
            const bool last = (t == nt - 2);
            const char* a1 = cA + (size_t)(t + 1) * kstep;
            const char* a2 = last ? nA : cA + (size_t)(t + 2) * kstep; const char* b2 = last ? nB : cB + (size_t)(t + 2) * kstep;
            const char* a3 = a2 + kstep; const char* b3 = b2 + kstep;
            if constexpr (SP2) {
            PG8_LDB(B0, 0, 0); PG8_LDB(B1, 0, 1); PG8_SCHED; PG8_LDA(At, 0, 0); PG8_STAGE(PG8_SA(1, 1), a1 + hstep, voffA);
            PG8_WAIT_V(8); PG8_WAIT_L(0); PG8_BAR; PG8_MMA(0, 0, At, B0); PG8_MMA(0, 1, At, B1); PG8_BAR; PG8_SCHED;
            PG8_LDA(At, 0, 1); PG8_STAGE(PG8_SB(0, 0), b2, voffB); PG8_STAGE(PG8_SB(0, 1), b2 + bhstep, voffB); PG8_STAGE(PG8_SA(0, 0), a2, voffA);
            PG8_WAIT_V(8); PG8_WAIT_L(0); PG8_BAR; PG8_MMA(1, 0, At, B0); PG8_MMA(1, 1, At, B1); PG8_BAR; PG8_SCHED;
            PG8_LDB(B0, 1, 0); PG8_LDB(B1, 1, 1); PG8_SCHED; PG8_LDA(At, 1, 0); PG8_STAGE(PG8_SA(0, 1), a2 + hstep, voffA);
            PG8_WAIT_V(8); PG8_WAIT_L(0); PG8_BAR; PG8_MMA(0, 0, At, B0); PG8_MMA(0, 1, At, B1); PG8_BAR; PG8_SCHED;
            PG8_LDA(At, 1, 1); PG8_STAGE(PG8_SB(1, 0), b3, voffB); PG8_STAGE(PG8_SB(1, 1), b3 + bhstep, voffB); PG8_STAGE(PG8_SA(1, 0), a3, voffA);
            PG8_WAIT_V(8); PG8_WAIT_L(0); PG8_BAR; PG8_MMA(1, 0, At, B0); PG8_MMA(1, 1, At, B1); PG8_BAR; PG8_SCHED;
            } else {
            PG8_LDB(B0, 0, 0); PG8_SCHED; PG8_LDA(At, 0, 0); PG8_STAGE(PG8_SA(1, 1), a1 + hstep, voffA);
            PG8_WAIT_L(8); PG8_BAR; PG8_WAIT_L(0); PG8_MMA(0, 0, At, B0); PG8_BAR; PG8_SCHED;
            PG8_LDB(B1, 0, 1); PG8_STAGE(PG8_SB(0, 0), b2, voffB);
            PG8_BAR; PG8_WAIT_L(0); PG8_MMA(0, 1, At, B1); PG8_BAR;
            PG8_LDA(At, 0, 1); PG8_STAGE(PG8_SA(0, 0), a2, voffA);
            PG8_BAR; PG8_WAIT_L(0); PG8_MMA(1, 0, At, B0); PG8_BAR; PG8_SCHED;
            PG8_STAGE(PG8_SB(0, 1), b2 + bhstep, voffB);
            PG8_WAIT_V(6); PG8_BAR; PG8_MMA(1, 1, At, B1); PG8_BAR;
            PG8_LDB(B0, 1, 0); PG8_SCHED; PG8_LDA(At, 1, 0); PG8_STAGE(PG8_SA(0, 1), a2 + hstep, voffA);
            PG8_WAIT_L(8); PG8_BAR; PG8_WAIT_L(0); PG8_MMA(0, 0, At, B0); PG8_BAR; PG8_SCHED;
            PG8_LDB(B1, 1, 1); PG8_STAGE(PG8_SB(1, 0), b3, voffB);
            PG8_BAR; PG8_WAIT_L(0); PG8_MMA(0, 1, At, B1); PG8_BAR;
            PG8_LDA(At, 1, 1); PG8_STAGE(PG8_SA(1, 0), a3, voffA);
            PG8_BAR; PG8_WAIT_L(0); PG8_MMA(1, 0, At, B0); PG8_BAR; PG8_SCHED;
            PG8_STAGE(PG8_SB(1, 1), b3 + bhstep, voffB);
            PG8_WAIT_V(6); PG8_BAR; PG8_MMA(1, 1, At, B1); PG8_BAR;
            }
        }
        if constexpr (ALIGN_EPI) { if (wr == 0) PG8_BAR; }
        E(acc, cur, wr, wc, fr, fq);
        if (!has_next) break;
#pragma unroll
        for (int a = 0; a < 2; ++a)
#pragma unroll
            for (int b = 0; b < 2; ++b)
#pragma unroll
                for (int m = 0; m < 4; ++m)
#pragma unroll
                    for (int n = 0; n < 2; ++n) acc[a][b][m][n] = (f32x4){0.f, 0.f, 0.f, 0.f};
        cur = nxt; cA = nA; cB = nB; ++ui;
        if constexpr (ALIGN_EPI) { if (wr == 1) PG8_BAR; }
    }
    PG8_WAIT_V(0);
    if constexpr (!ALIGN_EPI) { if (wr == 0) PG8_BAR; }
    PG8_BAR;
#undef PG8_SA
#undef PG8_SB
#undef PG8_STAGE
#undef PG8_LDA
#undef PG8_LDB
#undef PG8_MMA
#undef PG8_WAIT_V
#undef PG8_WAIT_L
#undef PG8_BAR
#undef PG8_SCHED
}
}

using pg8::bf16_t; using pg8::f32x4; using pg8::u32x4; using pg8::u32x2; using pg8::bf16x8; using pg8::cvt_pk_bf16; using pg8::Unit;
typedef float f32x16 __attribute__((ext_vector_type(16)));
typedef short s16x4 __attribute__((ext_vector_type(4)));

#define GAS __attribute__((address_space(1)))
#define LAS __attribute__((address_space(3)))
typedef GAS unsigned gu32;
#define RLX_AGENT __ATOMIC_RELAXED, __HIP_MEMORY_SCOPE_AGENT

__device__ __forceinline__ float bf2f(unsigned short h) { return __uint_as_float((unsigned)h << 16); }
__device__ __forceinline__ float bflo(unsigned w) { return __uint_as_float(w << 16); }
__device__ __forceinline__ float bfhi(unsigned w) { return __uint_as_float(w & 0xffff0000u); }
__device__ __forceinline__ u32x2 pack4(f32x4 v) { u32x2 w; w.x = cvt_pk_bf16(v[0], v[1]); w.y = cvt_pk_bf16(v[2], v[3]); return w; }
__device__ __forceinline__ float rstd_of(const float* ss, int r) { return 1.0f / sqrtf(ss[r] * (1.0f / DM) + RMS_EPS); }
template <int NP> __device__ __forceinline__ float rstd_row(const float* ss, int r, int fq) {
    if (NP == 1) return rstd_of(ss, r);
    float q = (ss[(size_t)(4 * fq + 0) * MT + r] + ss[(size_t)(4 * fq + 1) * MT + r]) + (ss[(size_t)(4 * fq + 2) * MT + r] + ss[(size_t)(4 * fq + 3) * MT + r]);
    q += __shfl_xor(q, 16); q += __shfl_xor(q, 32);
    return 1.0f / sqrtf(q * (1.0f / DM) + RMS_EPS);
}
__device__ __forceinline__ float sigmoidf_(float v) { return __builtin_amdgcn_rcpf(1.0f + __builtin_amdgcn_exp2f(-1.4426950408889634f * v)); }

template <int NP> struct EpiUp {
    static constexpr int PERM = 1;
    bf16_t* H; const float* ss;
    __device__ __forceinline__ void operator()(const f32x4 (&acc)[2][2][4][2], const Unit& u, int wr, int wc, int fr, int fq) const {
        const int row0 = u.pm * 256 + wr * 64 + fr, col0 = u.pn * 128 + wc * 32 + 8 * fq;
#pragma unroll
        for (int ai = 0; ai < 2; ++ai)
#pragma unroll
            for (int m = 0; m < 4; ++m) {
                const int r = row0 + ai * 128 + m * 16; const float rs = rstd_row<NP>(ss, r, fq);
                f32x4 h[2];
#pragma unroll
                for (int n = 0; n < 2; ++n) { const f32x4 gt = acc[ai][0][m][n] * rs, up = acc[ai][1][m][n] * rs;
#pragma unroll
                    for (int e = 0; e < 4; ++e) h[n][e] = gt[e] * sigmoidf_(gt[e]) * up[e]; }
                u32x4 w; w.x = cvt_pk_bf16(h[0][0], h[0][1]); w.y = cvt_pk_bf16(h[0][2], h[0][3]); w.z = cvt_pk_bf16(h[1][0], h[1][1]); w.w = cvt_pk_bf16(h[1][2], h[1][3]);
                *(u32x4*)(H + (size_t)r * FF + col0) = w;
            }
    }
};

struct EpiRes {
    static constexpr int PERM = 0;
    const float* src_p; float* dst_p; bf16_t* XB; float* ss_out; float scale;
    __device__ __forceinline__ void operator()(const f32x4 (&acc)[2][2][4][2], const Unit& u, int wr, int wc, int fr, int fq) const {
        const int row0 = u.pm * 256 + wr * 64 + fr, col0 = u.pn * 256 + wc * 32 + 4 * fq;
        const float* s = src_p; float* d = dst_p;
#pragma unroll
        for (int ai = 0; ai < 2; ++ai)
#pragma unroll
            for (int m = 0; m < 4; ++m) {
                const int r = row0 + ai * 128 + m * 16; const size_t off = (size_t)r * DM + col0; float q = 0.f;
#pragma unroll
                for (int bj = 0; bj < 2; ++bj)
#pragma unroll
                    for (int n = 0; n < 2; ++n) { const size_t o = off + bj * 128 + n * 16; const f32x4 x = *(const f32x4*)(s + o);
                        const f32x4 v = x + acc[ai][bj][m][n] * scale;
                        *(f32x4*)(d + o) = v; if (XB) *(u32x2*)(XB + o) = pack4(v);
                        q += (v[0] * v[0] + v[1] * v[1]) + (v[2] * v[2] + v[3] * v[3]); }
                q += __shfl_xor(q, 16); q += __shfl_xor(q, 32);
                if (fq == 0) ss_out[(size_t)(u.pn * 4 + wc) * MT + r] = q;
            }
    }
};

__device__ __forceinline__ void sincos_rev(float ang, float& s, float& c) {
    const float C_hi = 0.15915494f, C_lo = 6.4206383e-09f;
    const float p = ang * C_hi; float e = __builtin_fmaf(ang, C_hi, -p); e = __builtin_fmaf(ang, C_lo, e);
    const float f = __builtin_amdgcn_fractf(p) + e;
    s = __builtin_amdgcn_sinf(f); c = __builtin_amdgcn_cosf(f);
}

struct EpiIn {
    static constexpr int PERM = 2;
    const float* ss; bf16_t* U; bf16_t* QKV; bf16_t* G; float* out;
    __device__ __forceinline__ void operator()(const f32x4 (&acc)[2][2][4][2], const Unit& u, int wr, int wc, int fr, int fq) const {
        const int row0 = u.pm * 256 + wr * 64 + fr;
        const int hsel = wc >> 1, dlo = 16 * (wc & 1) + 4 * fq;
        const int cb = 64 * hsel + dlo;
        const int pn = u.pn;
        if (pn < 2) {
#pragma unroll
            for (int ai = 0; ai < 2; ++ai)
#pragma unroll
                for (int m = 0; m < 4; ++m) {
                    const int r = row0 + ai * 128 + m * 16; const float rs = rstd_row<16>(ss, r, fq);
                    const int t = r & (SEQ - 1), b = r >> 11; float* po = nullptr;
                    if (t >= SEQ - 15) po = out + O_POOLP + (size_t)(b * 15 + (t - (SEQ - 15))) * PW;
#pragma unroll
                    for (int bj = 0; bj < 2; ++bj)
#pragma unroll
                        for (int n = 0; n < 2; ++n) { const int c = pn * 256 + 128 * bj + 32 * n + cb; const f32x4 v = acc[ai][bj][m][n] * rs;
                            *(u32x2*)(U + (size_t)r * PW + c) = pack4(v); if (po) *(f32x4*)(po + c) = v; }
                }
        } else if (pn < 11) {
            const int j = pn - 2, g = j / 3, which = j - 3 * g;
            const int W = 128 << (2 * g);
            const size_t okp = (g == 0) ? O_KV128P : (g == 1) ? O_KV512P : O_KV2048P;
            float inv[4];
#pragma unroll
            for (int e = 0; e < 4; ++e) inv[e] = __builtin_amdgcn_exp2f(-(float)(dlo + e) * (13.287712379549449f / 32.0f));
#pragma unroll
            for (int ai = 0; ai < 2; ++ai)
#pragma unroll
                for (int m = 0; m < 4; ++m) {
                    const int r = row0 + ai * 128 + m * 16; const float rs = rstd_row<16>(ss, r, fq);
                    const int t = r & (SEQ - 1), b = r >> 11; float* kvo = nullptr;
                    if (which != 0 && t >= SEQ - W) kvo = out + okp + ((size_t)(b * W + (t - (SEQ - W))) * 2 + (which - 1)) * 256;
                    bf16_t* qrow = QKV + (size_t)r * QKVW + g * 768 + which * 256;
                    if (which == 2) {
#pragma unroll
                        for (int bj = 0; bj < 2; ++bj)
#pragma unroll
                            for (int n = 0; n < 2; ++n) { const int hd = (2 * bj + hsel) * 64 + 32 * n + dlo; const f32x4 v = acc[ai][bj][m][n] * rs;
                                *(u32x2*)(qrow + hd) = pack4(v); if (kvo) *(f32x4*)(kvo + hd) = v; }
                    } else {
                        const float pos = (float)t;
                        f32x4 cs, sn;
#pragma unroll
                        for (int e = 0; e < 4; ++e) { float s_, c_; sincos_rev(pos * inv[e], s_, c_); cs[e] = c_; sn[e] = s_; }
                        const float sc = (which == 0) ? rs * C2 : rs;
#pragma unroll
                        for (int bj = 0; bj < 2; ++bj) { const int hd = (2 * bj + hsel) * 64 + dlo; const f32x4 t1 = acc[ai][bj][m][0] * sc, t2 = acc[ai][bj][m][1] * sc;
                            const f32x4 o1 = t1 * cs - t2 * sn, o2 = t1 * sn + t2 * cs;
                            *(u32x2*)(qrow + hd) = pack4(o1); *(u32x2*)(qrow + hd + 32) = pack4(o2);
                            if (kvo) { *(f32x4*)(kvo + hd) = o1; *(f32x4*)(kvo + hd + 32) = o2; } }
                    }
                }
        } else {
#pragma unroll
            for (int ai = 0; ai < 2; ++ai)
#pragma unroll
                for (int m = 0; m < 4; ++m) {
                    const int r = row0 + ai * 128 + m * 16; const float rs = rstd_row<16>(ss, r, fq);
#pragma unroll
                    for (int bj = 0; bj < 2; ++bj)
#pragma unroll
                        for (int n = 0; n < 2; ++n) { const int c = (pn - 11) * 256 + 128 * bj + 32 * n + cb; const f32x4 v = acc[ai][bj][m][n] * rs; f32x4 sg;
#pragma unroll
                            for (int e = 0; e < 4; ++e) sg[e] = sigmoidf_(v[e]);
                            *(u32x2*)(G + (size_t)r * GW + c) = pack4(sg); }
                }
        }
    }
};

template <int SECOND> struct EpiBr {
    static constexpr int PERM = 1;
    const bf16_t* G; bf16_t* T1; bf16_t* MG;
    __device__ __forceinline__ void operator()(const f32x4 (&acc)[2][2][4][2], const Unit& u, int wr, int wc, int fr, int fq) const {
        const int row0 = u.pm * 256 + wr * 64 + fr, col0 = u.pn * 256 + wc * 32 + 8 * fq;
#pragma unroll
        for (int ai = 0; ai < 2; ++ai)
#pragma unroll
            for (int m = 0; m < 4; ++m) {
                const int r = row0 + ai * 128 + m * 16;
#pragma unroll
                for (int bj = 0; bj < 2; ++bj) { const int c = col0 + bj * 128;
                    const u32x4 gw = *(const u32x4*)(G + (size_t)r * GW + SECOND * DM + c);
                    const f32x4 a0 = acc[ai][bj][m][0], a1 = acc[ai][bj][m][1];
                    float v[8] = {a0[0] * bflo(gw.x), a0[1] * bfhi(gw.x), a0[2] * bflo(gw.y), a0[3] * bfhi(gw.y), a1[0] * bflo(gw.z), a1[1] * bfhi(gw.z), a1[2] * bflo(gw.w), a1[3] * bfhi(gw.w)};
                    if (SECOND) { const u32x4 tw = *(const u32x4*)(T1 + (size_t)r * DM + c);
                        v[0] += bflo(tw.x); v[1] += bfhi(tw.x); v[2] += bflo(tw.y); v[3] += bfhi(tw.y); v[4] += bflo(tw.z); v[5] += bfhi(tw.z); v[6] += bflo(tw.w); v[7] += bfhi(tw.w); }
                    u32x4 w; w.x = cvt_pk_bf16(v[0], v[1]); w.y = cvt_pk_bf16(v[2], v[3]); w.z = cvt_pk_bf16(v[4], v[5]); w.w = cvt_pk_bf16(v[6], v[7]);
                    *(u32x4*)((SECOND ? MG : T1) + (size_t)r * DM + c) = w; }
            }
    }
};

constexpr size_t MiB = 1u << 20;
constexpr size_t WS_CTL = 0, CTL_ZERO_BYTES = 1 * MiB;
constexpr int CW_BAR = 4096;
constexpr int CW_SS = 16384;
static_assert((CW_SS + MT) * 4 <= (int)CTL_ZERO_BYTES, "ctl");
constexpr size_t WS_W1UP = 1 * MiB;
constexpr size_t WS_W1DN = WS_W1UP + (size_t)2 * FF * DM * 2;
constexpr size_t WS_WIN = WS_W1DN + (size_t)DM * FF * 2;
constexpr size_t WS_WCOMB = WS_WIN + (size_t)INW * DM * 2;
constexpr size_t WS_WAB = WS_WCOMB + (size_t)DM * PW * 2;
constexpr size_t WS_WO = WS_WAB + (size_t)DM * AW * 2;
constexpr size_t WS_W2UP = WS_WO + (size_t)DM * DM * 2;
constexpr size_t WS_W2DN = WS_W2UP + (size_t)2 * FF * DM * 2;
constexpr size_t WS_XS = WS_W2DN + (size_t)DM * FF * 2;
constexpr size_t WS_XB = WS_XS + (size_t)256 * DM * 4;
constexpr size_t WS_OG = WS_XB;
constexpr size_t WS_LSE = WS_OG + (size_t)MT * 768 * 2;
constexpr size_t WS_Z = WS_XB + (size_t)MT * DM * 2;
static_assert(WS_LSE + (size_t)MT * 12 * 4 <= WS_Z, "OG/LSE overlay fits in XB");
constexpr size_t WS_H = WS_Z;
constexpr size_t WS_U = WS_Z;
constexpr size_t WS_QKV = WS_U + (size_t)MT * PW * 2;
constexpr size_t WS_T1 = WS_QKV, WS_MG = WS_QKV + (size_t)MT * DM * 2;
constexpr size_t WS_G = WS_QKV + (size_t)MT * QKVW * 2;
static_assert(WS_MG + (size_t)MT * DM * 2 <= WS_G, "T1/MG overlay fits in QKV");
constexpr size_t WS_P = WS_G + (size_t)MT * GW * 2;
static_assert(WS_H + (size_t)MT * FF * 2 <= WS_P, "H overlay fits in Z");
constexpr size_t WS_ATT = WS_P + (size_t)MT * PW * 2;
constexpr size_t WS_SSP = WS_ATT + (size_t)MT * AW * 2;
constexpr size_t SSP_STRIDE = (size_t)16 * MT;
constexpr size_t WS_SSS = WS_SSP + 3 * SSP_STRIDE * 4;
constexpr size_t WS_END = WS_SSS + 3 * 64 * 32 * 4;

constexpr int RING_OFF = 0, RING_BYTES = 131072;
constexpr int LDSCTL_OFF = RING_BYTES, MISC_OFF = LDSCTL_OFF + 320;
constexpr int LDS_BYTES = 147456;
constexpr int NWAVES = 8;

#define XB_TMO      128
#define XB_XCNT(j)  (256  + 64 * (j))
#define XB_XSUB(j)  (1280 + 64 * (j))
#define XB_XGEN(j)  (2304 + 64 * (j))
#define XB_TOP      3328
#define XB_TOPGEN   3392
#define XCD_BAR_WORDS 3456
#define XB_SPIN_CAP (1u << 18)
__device__ __forceinline__ unsigned xb_ld(unsigned* p)              { return __hip_atomic_load(p, __ATOMIC_RELAXED, __HIP_MEMORY_SCOPE_AGENT); }
__device__ __forceinline__ unsigned xb_add(unsigned* p, unsigned v) { return __hip_atomic_fetch_add(p, v, __ATOMIC_RELAXED, __HIP_MEMORY_SCOPE_AGENT); }
__device__ __forceinline__ unsigned xb_xcc_id() { return (unsigned)__builtin_amdgcn_s_getreg((3 << 11) | 20) & 0xFu; }
#define XB_SPIN(cond, bar) do { unsigned _sp = 0; while (cond) { __builtin_amdgcn_s_sleep(1); \
    if ((++_sp & 255u) == 0u) { if (xb_ld(&(bar)[XB_TMO])) break; if (_sp > XB_SPIN_CAP) { atomicAdd(&(bar)[XB_TMO], 1u); break; } } } } while (0)
struct XcdBarrier { unsigned* bar; unsigned x; volatile LAS unsigned* st; };
__device__ __forceinline__ XcdBarrier xcd_barrier_post(unsigned* bar, volatile LAS unsigned* st) {
    XcdBarrier b; b.bar = bar; b.x = xb_xcc_id(); b.st = st;
    if (threadIdx.x == 0) (void)xb_add(&bar[XB_XCNT(b.x)], 1u);
    return b;
}
__device__ __forceinline__ void xcd_barrier_complete(unsigned* bar, unsigned x, unsigned& nloc, unsigned& nx) {
    const unsigned G = gridDim.x * gridDim.y * gridDim.z;
    unsigned sum, cnt, mine, sp = 0u;
    for (;;) {
        sum = 0u; cnt = 0u; mine = 0u;
#pragma unroll
        for (unsigned j = 0; j < 16; ++j) { const unsigned c = xb_ld(&bar[XB_XCNT(j)]); sum += c; cnt += (c > 0u) ? 1u : 0u; mine = (j == x) ? c : mine; }
        if (sum == G) break;
        __builtin_amdgcn_s_sleep(1);
        if ((++sp & 255u) == 0u) { if (xb_ld(&bar[XB_TMO])) break; if (sp > XB_SPIN_CAP) { atomicAdd(&bar[XB_TMO], 1u); break; } }
    }
    nloc = mine > 0u ? mine : 1u; nx = cnt > 0u ? cnt : 1u;
}
__device__ __forceinline__ void xcd_barrier(const XcdBarrier& b) {
    asm volatile("s_waitcnt vmcnt(0)" ::: "memory");
    __syncthreads();
    if (threadIdx.x == 0) {
        unsigned* bar = b.bar;
        __builtin_amdgcn_s_waitcnt(0);
        unsigned nloc = b.st[0], nx = b.st[1];
        if (nloc == 0u) { xcd_barrier_complete(bar, b.x, nloc, nx); b.st[0] = nloc; b.st[1] = nx; }
        const unsigned old = xb_add(&bar[XB_XSUB(b.x)], 1u);
        const unsigned gen = old / nloc;
        if (old + 1u == (gen + 1u) * nloc) {
            __builtin_amdgcn_fence(__ATOMIC_RELEASE, "agent");
            asm volatile("s_waitcnt vmcnt(0)" ::: "memory");
            const unsigned og = xb_add(&bar[XB_TOP], 1u);
            const unsigned tg = og / nx;
            if (og + 1u == (tg + 1u) * nx) xb_add(&bar[XB_TOPGEN], 1u);
            else XB_SPIN(xb_ld(&bar[XB_TOPGEN]) == tg, bar);
            __builtin_amdgcn_fence(__ATOMIC_ACQUIRE, "agent");
            xb_add(&bar[XB_XGEN(b.x)], 1u);
            asm volatile("s_waitcnt vmcnt(0)" ::: "memory");
        } else {
            XB_SPIN(xb_ld(&bar[XB_XGEN(b.x)]) == gen, bar);
            __builtin_amdgcn_fence(__ATOMIC_ACQUIRE, "agent");
            asm volatile("s_waitcnt vmcnt(0)" ::: "memory");
        }
    }
    __syncthreads();
}

struct Args { const float* in[22]; float* out; unsigned char* ws; int ph_lo, ph_hi; };
struct Frame {
    LAS unsigned char* lds; int tid, lane, wave, vcu, G;
};
#define LDS_WAIT() asm volatile("s_waitcnt lgkmcnt(0)" ::: "memory")


template <int NF> __device__ __forceinline__ void sk_mma(const bf16_t* A, int lda, const bf16_t* const (&Bp)[NF], int ldb, int k0, int k1, f32x4 (&acc)[2][NF], int lane) {
    const int fr = lane & 15, fq = lane >> 4;
    const bf16_t* a0 = A + (size_t)fr * lda + 8 * fq; const bf16_t* a1 = a0 + (size_t)16 * lda;
    const bf16_t* b[NF];
#pragma unroll
    for (int n = 0; n < NF; ++n) b[n] = Bp[n] + (size_t)fr * ldb + 8 * fq;
#pragma unroll 4
    for (int k = k0; k < k1; k += 32) {
        const bf16x8 av0 = *(const bf16x8*)(a0 + k), av1 = *(const bf16x8*)(a1 + k);
#pragma unroll
        for (int n = 0; n < NF; ++n) { const bf16x8 bv = *(const bf16x8*)(b[n] + k);
            acc[0][n] = __builtin_amdgcn_mfma_f32_16x16x32_bf16(bv, av0, acc[0][n], 0, 0, 0);
            acc[1][n] = __builtin_amdgcn_mfma_f32_16x16x32_bf16(bv, av1, acc[1][n], 0, 0, 0); }
    }
}
__device__ __forceinline__ void sk_rstd64(const float* sss, int fr, int fq, float& r0, float& r1) {
    float a = 0.f, b = 0.f;
#pragma unroll
    for (int k = 0; k < 16; ++k) { a += sss[(16 * fq + k) * 32 + fr]; b += sss[(16 * fq + k) * 32 + fr + 16]; }
    a += __shfl_xor(a, 16); a += __shfl_xor(a, 32); b += __shfl_xor(b, 16); b += __shfl_xor(b, 32);
    r0 = 1.0f / sqrtf(a * (1.0f / DM) + RMS_EPS); r1 = 1.0f / sqrtf(b * (1.0f / DM) + RMS_EPS);
}
__device__ __forceinline__ void sk_up(const Frame& F, const bf16_t* XB, const bf16_t* Wup, bf16_t* H, const float* ss0, const float* sss) {
    const int gw = F.vcu * NWAVES + F.wave, NGW = F.G * NWAVES, lane = F.lane, fr = lane & 15, fq = lane >> 4;
    for (int it = gw; it < FF / 16; it += NGW) {
        float rs[2];
        if (sss) sk_rstd64(sss, fr, fq, rs[0], rs[1]); else { rs[0] = rstd_of(ss0, MP + fr); rs[1] = rstd_of(ss0, MP + 16 + fr); }
        f32x4 acc[2][2] = {};
        const bf16_t* const Bp[2] = {Wup + (size_t)(16 * it) * DM, Wup + (size_t)(FF + 16 * it) * DM};
        sk_mma<2>(XB + (size_t)MP * DM, DM, Bp, DM, 0, DM, acc, lane);
#pragma unroll
        for (int m = 0; m < 2; ++m) { const f32x4 gt = acc[m][0] * rs[m], up = acc[m][1] * rs[m]; f32x4 h;
#pragma unroll
            for (int e = 0; e < 4; ++e) h[e] = gt[e] * sigmoidf_(gt[e]) * up[e];
            *(u32x2*)(H + (size_t)(MP + 16 * m + fr) * FF + 16 * it + 4 * fq) = pack4(h); }
    }
}
template <int KS> __device__ __forceinline__ void sk_res(const Frame& F, const bf16_t* A, int K, const bf16_t* Wt, float* XS, bf16_t* XBs, float* sss_out, float scale) {
    const int nwg = (64 * KS + NWAVES - 1) / NWAVES;
    if (F.vcu >= nwg) return;
    const int gw = F.vcu * NWAVES + F.wave, lane = F.lane, fr = lane & 15, fq = lane >> 4, it = gw / KS, sl = gw % KS;
    f32x4 acc[2][1] = {};
    if (it < 64) { const bf16_t* const Bp[1] = {Wt + (size_t)(16 * it) * K}; const int kc = K / KS; sk_mma<1>(A, K, Bp, K, sl * kc, (sl + 1) * kc, acc, lane); }
    LAS f32x4* red = (LAS f32x4*)(F.lds + 98304) + F.wave * 128;
    if (KS > 1) { red[lane] = acc[0][0]; red[64 + lane] = acc[1][0]; __syncthreads(); }
    if (it < 64 && sl == 0) {
#pragma unroll
        for (int k = 1; k < KS; ++k) { acc[0][0] += red[k * 128 + lane]; acc[1][0] += red[k * 128 + 64 + lane]; }
#pragma unroll
        for (int m = 0; m < 2; ++m) { const int row = 16 * m + fr; const size_t o = (size_t)row * DM + 16 * it + 4 * fq;
            const f32x4 v = *(const f32x4*)(XS + o) + acc[m][0] * scale; *(f32x4*)(XS + o) = v;
            if (XBs) *(u32x2*)(XBs + o) = pack4(v);
            float q = (v[0] * v[0] + v[1] * v[1]) + (v[2] * v[2] + v[3] * v[3]); q += __shfl_xor(q, 16); q += __shfl_xor(q, 32);
            if (fq == 0) sss_out[it * 32 + row] = q; }
    }
    if (KS > 1) __syncthreads();
}
__device__ __forceinline__ void sk_in(const Frame& F, const bf16_t* XB, const bf16_t* Win, const float* sss, bf16_t* U, bf16_t* QKV, bf16_t* G, float* out) {
    const int gw = F.vcu * NWAVES + F.wave, NGW = F.G * NWAVES, lane = F.lane, fr = lane & 15, fq = lane >> 4;
    for (int it = gw; it < INW / 32; it += NGW) {
        const int blk = it >> 1, c0 = 64 * blk + 16 * (it & 1);
        float rs[2]; sk_rstd64(sss, fr, fq, rs[0], rs[1]);
        f32x4 acc[2][2] = {};
        const bf16_t* const Bp[2] = {Win + (size_t)c0 * DM, Win + (size_t)(c0 + 32) * DM};
        sk_mma<2>(XB + (size_t)MP * DM, DM, Bp, DM, 0, DM, acc, lane);
        const int cl = 16 * (it & 1) + 4 * fq;
#pragma unroll
        for (int m = 0; m < 2; ++m) {
            const int n = 16 * m + fr; const size_t r = (size_t)MP + n; const f32x4 z0 = acc[m][0] * rs[m], z1 = acc[m][1] * rs[m];
            if (blk < 8) {
                const int c = 64 * blk + cl; float* po = out + O_POOLS + (size_t)(n * 15 + 14) * PW;
                *(u32x2*)(U + r * PW + c) = pack4(z0); *(u32x2*)(U + r * PW + c + 32) = pack4(z1); *(f32x4*)(po + c) = z0; *(f32x4*)(po + c + 32) = z1;
            } else if (blk < 44) {
                const int j = blk - 8, g = j / 12, rem = j - 12 * g, which = rem >> 2, h = rem & 3, W = 128 << (2 * g);
                bf16_t* qrow = QKV + r * QKVW + g * 768 + which * 256 + h * 64 + cl;
                const size_t oks = (g == 0) ? O_KV128S : (g == 1) ? O_KV512S : O_KV2048S;
                float* kvo = out + oks + ((size_t)(n * W + (W - 1)) * 2 + (which - 1)) * 256 + h * 64 + cl;
                if (which == 2) { *(u32x2*)qrow = pack4(z0); *(u32x2*)(qrow + 32) = pack4(z1); *(f32x4*)kvo = z0; *(f32x4*)(kvo + 32) = z1; }
                else {
                    f32x4 cs, sn;
#pragma unroll
                    for (int e = 0; e < 4; ++e) { float s_, c_; sincos_rev((float)PAST * __builtin_amdgcn_exp2f(-(float)(cl + e) * (13.287712379549449f / 32.0f)), s_, c_); cs[e] = c_; sn[e] = s_; }
                    const float sc = (which == 0) ? C2 : 1.0f; const f32x4 t1 = z0 * sc, t2 = z1 * sc, o1 = t1 * cs - t2 * sn, o2 = t1 * sn + t2 * cs;
                    *(u32x2*)qrow = pack4(o1); *(u32x2*)(qrow + 32) = pack4(o2);
                    if (which == 1) { *(f32x4*)kvo = o1; *(f32x4*)(kvo + 32) = o2; }
                }
            } else {
                const int c = 64 * (blk - 44) + cl; f32x4 s0, s1;
#pragma unroll
                for (int e = 0; e < 4; ++e) { s0[e] = sigmoidf_(z0[e]); s1[e] = sigmoidf_(z1[e]); }
                *(u32x2*)(G + r * GW + c) = pack4(s0); *(u32x2*)(G + r * GW + c + 32) = pack4(s1);
            }
        }
    }
}
__device__ __forceinline__ void sk_br(const Frame& F, const bf16_t* P, const bf16_t* ATT, const bf16_t* Wcomb, const bf16_t* Wab, const bf16_t* G, bf16_t* MG) {
    const int gw = F.vcu * NWAVES + F.wave, NGW = F.G * NWAVES, lane = F.lane, fr = lane & 15, fq = lane >> 4;
    for (int it = gw; it < 64; it += NGW) {
        f32x4 ap[2][1] = {}, aa[2][1] = {};
        { const bf16_t* const Bp[1] = {Wcomb + (size_t)(16 * it) * PW}; sk_mma<1>(P + (size_t)MP * PW, PW, Bp, PW, 0, PW, ap, lane); }
        { const bf16_t* const Bp[1] = {Wab + (size_t)(16 * it) * AW}; sk_mma<1>(ATT + (size_t)MP * AW, AW, Bp, AW, 0, AW, aa, lane); }
#pragma unroll
        for (int m = 0; m < 2; ++m) { const size_t r = (size_t)MP + 16 * m + fr; const int c = 16 * it + 4 * fq;
            const u32x2 gp = *(const u32x2*)(G + r * GW + c), ga = *(const u32x2*)(G + r * GW + DM + c);
            f32x4 v; v[0] = ap[m][0][0] * bflo(gp.x) + aa[m][0][0] * bflo(ga.x); v[1] = ap[m][0][1] * bfhi(gp.x) + aa[m][0][1] * bfhi(ga.x);
            v[2] = ap[m][0][2] * bflo(gp.y) + aa[m][0][2] * bflo(ga.y); v[3] = ap[m][0][3] * bfhi(gp.y) + aa[m][0][3] * bfhi(ga.y);
            *(u32x2*)(MG + r * DM + c) = pack4(v); }
    }
}

__device__ __forceinline__ void p0_transpose_item(const float* W, const float* gain, int K, int N, bf16_t* WT, int row_off, LAS float* scr, int item, int lane) {
    const int nblk = N / 32, kb = item / nblk, nb = item % nblk, k0 = 64 * kb, n0 = 32 * nb;
#pragma unroll 8
    for (int i = 0; i < 32; ++i) { const int kk = 2 * i + (lane >> 5); float v = W[(size_t)(k0 + kk) * N + n0 + (lane & 31)]; if (gain) v *= gain[k0 + kk]; scr[kk * 33 + (lane & 31)] = v; }
    LDS_WAIT(); asm volatile("" ::: "memory");
    const int c = lane & 7;
#pragma unroll
    for (int j = 0; j < 4; ++j) { const int n = (lane >> 3) + 8 * j; const LAS float* s = scr + (8 * c) * 33 + n;
        u32x4 o; o.x = cvt_pk_bf16(s[0 * 33], s[1 * 33]); o.y = cvt_pk_bf16(s[2 * 33], s[3 * 33]); o.z = cvt_pk_bf16(s[4 * 33], s[5 * 33]); o.w = cvt_pk_bf16(s[6 * 33], s[7 * 33]);
        *(u32x4*)(WT + (size_t)(row_off + n0 + n) * K + k0 + 8 * c) = o; }
    LDS_WAIT(); asm volatile("" ::: "memory");
}
__device__ __forceinline__ float wave_sum(float v) {
#pragma unroll
    for (int o = 1; o < 64; o <<= 1) v += __shfl_xor(v, o);
    return v;
}

__device__ __forceinline__ void p0_prologue(const Frame& F, const Args& a) {
    unsigned char* ws = a.ws;
    LAS float* scr = (LAS float*)(F.lds + RING_OFF + F.wave * 16384);
    const int gw = F.vcu * NWAVES + F.wave, NGW = F.G * NWAVES;
    constexpr int I_UP = (DM / 64) * (FF / 32), I_DN = (FF / 64) * (DM / 32), I_IN = (DM / 64) * (INW / 32), I_AB = (AW / 64) * (DM / 32), I_O = (DM / 64) * (DM / 32), I_CMB = 1024;
    constexpr int NITEMS = 4 * I_UP + 2 * I_DN + I_IN + I_AB + I_O + I_CMB;
    for (int it = gw; it < NITEMS; it += NGW) {
        int r = it;
        if (r < I_UP) { p0_transpose_item(a.in[7], a.in[6], DM, FF, (bf16_t*)(ws + WS_W1UP), 0, scr, r, F.lane); continue; } r -= I_UP;
        if (r < I_UP) { p0_transpose_item(a.in[8], a.in[6], DM, FF, (bf16_t*)(ws + WS_W1UP), FF, scr, r, F.lane); continue; } r -= I_UP;
        if (r < I_DN) { p0_transpose_item(a.in[9], nullptr, FF, DM, (bf16_t*)(ws + WS_W1DN), 0, scr, r, F.lane); continue; } r -= I_DN;
        if (r < I_IN) { p0_transpose_item(a.in[11], a.in[10], DM, INW, (bf16_t*)(ws + WS_WIN), 0, scr, r, F.lane); continue; } r -= I_IN;
        if (r < I_AB) { p0_transpose_item(a.in[15], nullptr, AW, DM, (bf16_t*)(ws + WS_WAB), 0, scr, r, F.lane); continue; } r -= I_AB;
        if (r < I_O) { p0_transpose_item(a.in[16], nullptr, DM, DM, (bf16_t*)(ws + WS_WO), 0, scr, r, F.lane); continue; } r -= I_O;
        if (r < I_UP) { p0_transpose_item(a.in[18], a.in[17], DM, FF, (bf16_t*)(ws + WS_W2UP), 0, scr, r, F.lane); continue; } r -= I_UP;
        if (r < I_UP) { p0_transpose_item(a.in[19], a.in[17], DM, FF, (bf16_t*)(ws + WS_W2UP), FF, scr, r, F.lane); continue; } r -= I_UP;
        if (r < I_DN) { p0_transpose_item(a.in[20], nullptr, FF, DM, (bf16_t*)(ws + WS_W2DN), 0, scr, r, F.lane); continue; } r -= I_DN;
        {
            const int nb = r & 15, kc = r >> 4, k0 = kc * 8, g = k0 >> 7, c0 = k0 & 127, n = nb * 64 + F.lane;
            const float* wgrp = a.in[12] + (size_t)(g * 128 + c0) * 128; const float* scl = a.in[13] + g * 128; const float* wpb = a.in[14] + (size_t)(g * 128) * DM + n;
            float ac[8] = {0.f, 0.f, 0.f, 0.f, 0.f, 0.f, 0.f, 0.f};
            for (int d = 0; d < 128; ++d) { const float wv = wpb[(size_t)d * DM] * scl[d];
#pragma unroll
                for (int i = 0; i < 8; ++i) ac[i] += wgrp[i * 128 + d] * wv; }
            u32x4 o; o.x = cvt_pk_bf16(ac[0], ac[1]); o.y = cvt_pk_bf16(ac[2], ac[3]); o.z = cvt_pk_bf16(ac[4], ac[5]); o.w = cvt_pk_bf16(ac[6], ac[7]);
            *(u32x4*)((bf16_t*)(ws + WS_WCOMB) + (size_t)n * PW + k0) = o;
        }
    }
    float* ss0 = (float*)(ws + WS_CTL) + CW_SS;
    for (int m = gw; m < MP + NS; m += NGW) {
        const float* xr = (m < MP) ? a.in[0] + (size_t)m * DM : a.in[1] + (size_t)(m - MP) * DM;
        const f32x4* x4 = (const f32x4*)xr + F.lane; f32x4 v[4]; float s = 0.f;
#pragma unroll
        for (int j = 0; j < 4; ++j) { v[j] = x4[64 * j]; s += (v[j].x * v[j].x + v[j].y * v[j].y) + (v[j].z * v[j].z + v[j].w * v[j].w); }
        s = wave_sum(s);
        u32x2* o8 = (u32x2*)((bf16_t*)(ws + WS_XB) + (size_t)m * DM) + F.lane;
#pragma unroll
        for (int j = 0; j < 4; ++j) o8[64 * j] = pack4(v[j]);
        if (m >= MP) { f32x4* xs4 = (f32x4*)((float*)(ws + WS_XS) + (size_t)(m - MP) * DM) + F.lane;
#pragma unroll
            for (int j = 0; j < 4; ++j) xs4[64 * j] = v[j]; }
        if (F.lane == 0) ss0[m] = s;
    }
    const size_t gt = (size_t)F.vcu * (NWAVES * 64) + F.tid, NT = (size_t)F.G * NWAVES * 64;
#define COPY_SHIFT(src, dstoff, ROWS, RW4) do { const f32x4* s4 = (const f32x4*)(src); f32x4* d4 = (f32x4*)(a.out + (dstoff)); \
        const size_t per = (size_t)((ROWS) - 1) * (RW4), tot = (size_t)NS * per; \
        for (size_t i = gt; i < tot; i += NT) { const size_t n = i / per, rem = i - n * per; d4[n * (size_t)(ROWS) * (RW4) + rem] = s4[n * (size_t)(ROWS) * (RW4) + (RW4) + rem]; } } while (0)
    COPY_SHIFT(a.in[5], O_KV2048S, 2048, 128);
    COPY_SHIFT(a.in[4], O_KV512S, 512, 128);
    COPY_SHIFT(a.in[3], O_KV128S, 128, 128);
    COPY_SHIFT(a.in[2], O_POOLS, 15, 128);
#undef COPY_SHIFT
}

namespace att {
__device__ __forceinline__ int crow(int r, int hi) { return (r & 3) + 8 * (r >> 2) + 4 * hi; }
typedef short v4i16_t __attribute__((ext_vector_type(4)));
__device__ __forceinline__ s16x4 vtr(LAS const unsigned char* p) { return __builtin_bit_cast(s16x4, __builtin_amdgcn_ds_read_tr16_b64_v4i16((LAS v4i16_t*)p)); }
__device__ __forceinline__ float swapmax(float m) { auto rr = __builtin_amdgcn_permlane32_swap(__float_as_uint(m), __float_as_uint(m), false, false); return fmaxf(__uint_as_float(rr[0]), __uint_as_float(rr[1])); }
__device__ __forceinline__ float swapsum(float m) { auto rr = __builtin_amdgcn_permlane32_swap(__float_as_uint(m), __float_as_uint(m), false, false); return __uint_as_float(rr[0]) + __uint_as_float(rr[1]); }

__device__ __forceinline__ void task(const bf16_t* QKV, int colq, long kbase, int kstride, int qs0, int tlo, int thi, LAS unsigned char* vb,
                                     bf16_t* OGp  , float* LSEp  , int lane) {
    const int r32 = lane & 31, hi = lane >> 5;
    const long qrow = kbase + (long)(qs0 + r32) * kstride;
    bf16x8 qr[4];
#pragma unroll
    for (int d0 = 0; d0 < 4; ++d0) qr[d0] = *(const bf16x8*)(QKV + qrow * QKVW + colq + 16 * d0 + 8 * hi);
    const bf16_t* kcol = QKV + colq + 256 + 8 * hi;
    const bf16_t* vcol = QKV + colq + 512 + (lane & 7) * 8;
    const int vwoff = ((lane & 7) >> 2) * 2048 + ((lane & 7) & 3) * 16;
    const int vroff = ((lane >> 4) & 1) * 32 + (lane & 3) * 8 + (4 * hi + ((lane & 15) >> 2)) * 64;
    bf16x8 kf[4]; u32x4 vr[4];
    {
        const long kr = kbase + (long)(32 * tlo + r32) * kstride;
#pragma unroll
        for (int d0 = 0; d0 < 4; ++d0) kf[d0] = *(const bf16x8*)(kcol + kr * QKVW + 16 * d0);
#pragma unroll
        for (int i = 0; i < 4; ++i) { const long vrw = kbase + (long)(32 * tlo + i * 8 + (lane >> 3)) * kstride; vr[i] = *(const u32x4*)(vcol + vrw * QKVW); }
    }
    f32x16 o0 = {}, o1 = {}; float m_run = -1e30f, l_run = 0.f;
    for (int T = tlo; T <= thi; ++T) {
        LAS unsigned char* vbuf = vb + ((T & 1) ? 4096 : 0);
#pragma unroll
        for (int i = 0; i < 4; ++i) { const int row = i * 8 + (lane >> 3); *(LAS u32x4*)(vbuf + vwoff + (row >> 4) * 1024 + (row & 15) * 64) = vr[i]; }
        bf16x8 kn[4]; u32x4 vn[4];
        const int Tn = (T < thi) ? T + 1 : T;
        {
            const long kr = kbase + (long)(32 * Tn + r32) * kstride;
#pragma unroll
            for (int d0 = 0; d0 < 4; ++d0) kn[d0] = *(const bf16x8*)(kcol + kr * QKVW + 16 * d0);
#pragma unroll
            for (int i = 0; i < 4; ++i) { const long vrw = kbase + (long)(32 * Tn + i * 8 + (lane >> 3)) * kstride; vn[i] = *(const u32x4*)(vcol + vrw * QKVW); }
        }
        f32x16 p = {};
#pragma unroll
        for (int d0 = 0; d0 < 4; ++d0) p = __builtin_amdgcn_mfma_f32_32x32x16_bf16(kf[d0], qr[d0], p, 0, 0, 0);
        if (T == tlo || T == thi) {
            const int qs = qs0 + r32;
#pragma unroll
            for (int r = 0; r < 16; ++r) { const int ks = 32 * T + crow(r, hi); if (ks > qs || ks < qs - 128) p[r] = -1e30f; }
        }
        float rm = p[0];
#pragma unroll
        for (int r = 1; r < 16; ++r) rm = fmaxf(rm, p[r]);
        rm = swapmax(rm);
        const float mn = fmaxf(m_run, rm), alpha = __builtin_amdgcn_exp2f(m_run - mn); m_run = mn;
        float ls = 0.f;
#pragma unroll
        for (int r = 0; r < 16; ++r) { p[r] = __builtin_amdgcn_exp2f(p[r] - mn); ls += p[r]; }
        l_run = l_run * alpha + ls;
#pragma unroll
        for (int r = 0; r < 16; ++r) { o0[r] *= alpha; o1[r] *= alpha; }
        u32x4 pw0, pw1;
        pw0.x = cvt_pk_bf16(p[0], p[1]); pw0.y = cvt_pk_bf16(p[2], p[3]); pw0.z = cvt_pk_bf16(p[4], p[5]); pw0.w = cvt_pk_bf16(p[6], p[7]);
        pw1.x = cvt_pk_bf16(p[8], p[9]); pw1.y = cvt_pk_bf16(p[10], p[11]); pw1.z = cvt_pk_bf16(p[12], p[13]); pw1.w = cvt_pk_bf16(p[14], p[15]);
        const LAS unsigned char* vp = vbuf + vroff;
#define VFRAG(d0, s) ({ const s16x4 lo_ = vtr(vp + (d0) * 2048 + (s) * 1024), hi_ = vtr(vp + (d0) * 2048 + (s) * 1024 + 512); \
            (bf16x8){lo_[0], lo_[1], lo_[2], lo_[3], hi_[0], hi_[1], hi_[2], hi_[3]}; })
        o0 = __builtin_amdgcn_mfma_f32_32x32x16_bf16(VFRAG(0, 0), __builtin_bit_cast(bf16x8, pw0), o0, 0, 0, 0);
        o0 = __builtin_amdgcn_mfma_f32_32x32x16_bf16(VFRAG(0, 1), __builtin_bit_cast(bf16x8, pw1), o0, 0, 0, 0);
        o1 = __builtin_amdgcn_mfma_f32_32x32x16_bf16(VFRAG(1, 0), __builtin_bit_cast(bf16x8, pw0), o1, 0, 0, 0);
        o1 = __builtin_amdgcn_mfma_f32_32x32x16_bf16(VFRAG(1, 1), __builtin_bit_cast(bf16x8, pw1), o1, 0, 0, 0);
#undef VFRAG
#pragma unroll
        for (int d0 = 0; d0 < 4; ++d0) kf[d0] = kn[d0];
#pragma unroll
        for (int i = 0; i < 4; ++i) vr[i] = vn[i];
    }
    const float lt = swapsum(l_run), il = 1.0f / lt;
    bf16_t* op = OGp + qrow * 768;
#pragma unroll
    for (int a4 = 0; a4 < 4; ++a4) {
        u32x2 w0, w1;
        w0.x = cvt_pk_bf16(o0[4 * a4] * il, o0[4 * a4 + 1] * il); w0.y = cvt_pk_bf16(o0[4 * a4 + 2] * il, o0[4 * a4 + 3] * il);
        w1.x = cvt_pk_bf16(o1[4 * a4] * il, o1[4 * a4 + 1] * il); w1.y = cvt_pk_bf16(o1[4 * a4 + 2] * il, o1[4 * a4 + 3] * il);
        *(u32x2*)(op + 8 * a4 + 4 * hi) = w0; *(u32x2*)(op + 32 + 8 * a4 + 4 * hi) = w1;
    }
    if (hi == 0) LSEp[qrow * 12] = m_run + __builtin_amdgcn_logf(lt);
}

__device__ __forceinline__ void sample_task(const bf16_t* QKV, const float* cache, int W, int dil, int n, int h, int g, LAS float* sc, bf16_t* OG, float* LSE, int lane) {
    const long row = MP + n; const bf16_t* qp = QKV + row * QKVW + g * 768 + h * 64;
    const int dch = lane & 15, jl = lane >> 4;
    f32x4 q4; { const u32x2 w = *(const u32x2*)(qp + 4 * dch); q4 = (f32x4){bflo(w.x), bfhi(w.x), bflo(w.y), bfhi(w.y)}; }
    for (int it = 0; it < 33; ++it) {
        const int j = 4 * it + jl; f32x4 k4 = {0.f, 0.f, 0.f, 0.f};
        if (j == 0) { const u32x2 w = *(const u32x2*)(qp + 256 + 4 * dch); k4 = (f32x4){bflo(w.x), bfhi(w.x), bflo(w.y), bfhi(w.y)}; }
        else if (j <= 128) k4 = *(const f32x4*)(cache + ((size_t)(n * W + (W - dil * j)) * 2 + 0) * 256 + h * 64 + 4 * dch);
        float s = (k4[0] * q4[0] + k4[1] * q4[1]) + (k4[2] * q4[2] + k4[3] * q4[3]);
        s += __shfl_xor(s, 1); s += __shfl_xor(s, 2); s += __shfl_xor(s, 4); s += __shfl_xor(s, 8);
        if (dch == 0) sc[j] = (j <= 128) ? s : -1e30f;
    }
    LDS_WAIT(); asm volatile("" ::: "memory");
    float s0 = sc[lane], s1 = sc[lane + 64], s2 = (lane < 4) ? sc[lane + 128] : -1e30f;
    float mx = fmaxf(fmaxf(s0, s1), s2);
#pragma unroll
    for (int o = 1; o < 64; o <<= 1) mx = fmaxf(mx, __shfl_xor(mx, o));
    const float p0 = __builtin_amdgcn_exp2f(s0 - mx), p1 = __builtin_amdgcn_exp2f(s1 - mx), p2 = __builtin_amdgcn_exp2f(s2 - mx);
    const float l = wave_sum(p0 + p1 + p2);
    LDS_WAIT(); asm volatile("" ::: "memory");
    sc[lane] = p0; sc[lane + 64] = p1; if (lane < 4) sc[lane + 128] = p2;
    LDS_WAIT(); asm volatile("" ::: "memory");
    f32x4 ac = {0.f, 0.f, 0.f, 0.f};
    for (int it = 0; it < 33; ++it) {
        const int j = 4 * it + jl; f32x4 v4 = {0.f, 0.f, 0.f, 0.f}; const float pj = sc[j];
        if (j == 0) { const u32x2 w = *(const u32x2*)(qp + 512 + 4 * dch); v4 = (f32x4){bflo(w.x), bfhi(w.x), bflo(w.y), bfhi(w.y)}; }
        else if (j <= 128) v4 = *(const f32x4*)(cache + ((size_t)(n * W + (W - dil * j)) * 2 + 1) * 256 + h * 64 + 4 * dch);
        ac += v4 * pj;
    }
#pragma unroll
    for (int e = 0; e < 4; ++e) { ac[e] += __shfl_xor(ac[e], 16); ac[e] += __shfl_xor(ac[e], 32); }
    const float il = 1.0f / l;
    if (lane < 16) *(u32x2*)(OG + row * 768 + g * 256 + h * 64 + 4 * dch) = pack4(ac * il);
    if (lane == 0) LSE[row * 12 + g * 4 + h] = mx + __builtin_amdgcn_logf(l);
    LDS_WAIT(); asm volatile("" ::: "memory");
}

__device__ __forceinline__ void merge_row(const bf16_t* OG, const float* LSE, bf16_t* ATT, long row, int h, int ch) {
    const float l0 = LSE[row * 12 + h], l1 = LSE[row * 12 + 4 + h], l2 = LSE[row * 12 + 8 + h];
    const float mx = fmaxf(fmaxf(l0, l1), l2);
    float w0 = __builtin_amdgcn_exp2f(l0 - mx), w1 = __builtin_amdgcn_exp2f(l1 - mx), w2 = __builtin_amdgcn_exp2f(l2 - mx);
    const float inv = 1.0f / (w0 + w1 + w2); w0 *= inv; w1 *= inv; w2 *= inv;
    const bf16_t* p = OG + row * 768 + h * 64 + 8 * ch;
    const u32x4 a = *(const u32x4*)p, b = *(const u32x4*)(p + 256), c = *(const u32x4*)(p + 512);
    u32x4 o;
    o.x = cvt_pk_bf16(w0 * bflo(a.x) + w1 * bflo(b.x) + w2 * bflo(c.x), w0 * bfhi(a.x) + w1 * bfhi(b.x) + w2 * bfhi(c.x));
    o.y = cvt_pk_bf16(w0 * bflo(a.y) + w1 * bflo(b.y) + w2 * bflo(c.y), w0 * bfhi(a.y) + w1 * bfhi(b.y) + w2 * bfhi(c.y));
    o.z = cvt_pk_bf16(w0 * bflo(a.z) + w1 * bflo(b.z) + w2 * bflo(c.z), w0 * bfhi(a.z) + w1 * bfhi(b.z) + w2 * bfhi(c.z));
    o.w = cvt_pk_bf16(w0 * bflo(a.w) + w1 * bflo(b.w) + w2 * bflo(c.w), w0 * bfhi(a.w) + w1 * bfhi(b.w) + w2 * bfhi(c.w));
    *(u32x4*)(ATT + row * AW + h * 64 + 8 * ch) = o;
}
}

__device__ __forceinline__ void p4_mixers(const Frame& F, const Args& a) {
    unsigned char* ws = a.ws;
    const bf16_t* QKV = (const bf16_t*)(ws + WS_QKV); const bf16_t* U = (const bf16_t*)(ws + WS_U);
    bf16_t* OG = (bf16_t*)(ws + WS_OG); float* LSE = (float*)(ws + WS_LSE); bf16_t* ATT = (bf16_t*)(ws + WS_ATT); bf16_t* P = (bf16_t*)(ws + WS_P);
    const int lane = F.lane, wv = F.wave;
    for (int unit = F.vcu; unit < 256; unit += F.G) {
        const int b = unit >> 4, h = (unit >> 2) & 3, blk = unit & 3;
        if (unit < 128 && wv < 3) {
            const int n = unit >> 2, hh = unit & 3;
            const float* cache = (wv == 0) ? a.in[3] : (wv == 1) ? a.in[4] : a.in[5];
            att::sample_task(QKV, cache, 128 << (2 * wv), 1 << (2 * wv), n, hh, wv, (LAS float*)(F.lds + 65536 + wv * 1024), OG, LSE, lane);
        }
        LAS unsigned char* vb = F.lds + wv * 8192;
        const long tok0 = (long)b * SEQ;
#pragma unroll 1
        for (int g = 0; g < 3; ++g) {
            const int dil = 1 << (2 * g), ns = 512 / dil;
#pragma unroll 1
            for (int sub = 0; sub < 2; ++sub) {
                const int f = (2 * wv + sub) * 32;
                const int rho = f / ns, sl = f - rho * ns;
                const int qs0 = blk * ns + sl;
                const int tlo = (qs0 >= 128) ? (qs0 - 128) / 32 : 0, thi = qs0 / 32;
                att::task(QKV, g * 768 + h * 64, tok0 + rho, dil, qs0, tlo, thi, vb, OG + g * 256 + h * 64, LSE + g * 4 + h, lane);
            }
        }
        {
            const int gi = h, w = 2 << gi, ch = F.tid & 15, rg = F.tid >> 4, t0 = blk * 512 + rg * 16;
            const bf16_t* up = U + (size_t)tok0 * PW + gi * 128 + ch * 8; bf16_t* pp = P + (size_t)tok0 * PW + gi * 128 + ch * 8;
            float S[8] = {0.f, 0.f, 0.f, 0.f, 0.f, 0.f, 0.f, 0.f};
            for (int i = 1; i < w; ++i) { const int t = t0 - i; if (t >= 0) { const u32x4 x = *(const u32x4*)(up + (size_t)t * PW);
                S[0] += bflo(x.x); S[1] += bfhi(x.x); S[2] += bflo(x.y); S[3] += bfhi(x.y); S[4] += bflo(x.z); S[5] += bfhi(x.z); S[6] += bflo(x.w); S[7] += bfhi(x.w); } }
#pragma unroll 4
            for (int i = 0; i < 16; ++i) { const int t = t0 + i; const u32x4 x = *(const u32x4*)(up + (size_t)t * PW);
                const float xv[8] = {bflo(x.x), bfhi(x.x), bflo(x.y), bfhi(x.y), bflo(x.z), bfhi(x.z), bflo(x.w), bfhi(x.w)};
                const float ic = 1.0f / (float)((t + 1 < w) ? t + 1 : w); float pv[8];
#pragma unroll
                for (int e = 0; e < 8; ++e) { S[e] += xv[e]; pv[e] = S[e] * ic - xv[e]; }
                u32x4 o; o.x = cvt_pk_bf16(pv[0], pv[1]); o.y = cvt_pk_bf16(pv[2], pv[3]); o.z = cvt_pk_bf16(pv[4], pv[5]); o.w = cvt_pk_bf16(pv[6], pv[7]);
                *(u32x4*)(pp + (size_t)t * PW) = o;
                const int tb = t - w + 1; if (tb >= 0) { const u32x4 y = *(const u32x4*)(up + (size_t)tb * PW);
                    S[0] -= bflo(y.x); S[1] -= bfhi(y.x); S[2] -= bflo(y.y); S[3] -= bfhi(y.y); S[4] -= bflo(y.z); S[5] -= bfhi(y.z); S[6] -= bflo(y.w); S[7] -= bfhi(y.w); } }
        }
        if (unit >= 128 && unit < 160) {
            const int n = unit - 128, c = F.tid, gi = c >> 7, w = 2 << gi;
            const float un = bf2f(U[(size_t)(MP + n) * PW + c]); float S = un; const float* sp = a.in[2] + (size_t)n * 15 * PW + c;
            for (int i = 1; i < w; ++i) S += sp[(size_t)(15 - i) * PW];
            const float pv = S / (float)w - un;
            P[(size_t)(MP + n) * PW + c] = (bf16_t)(cvt_pk_bf16(pv, 0.f) & 0xffffu);
        }
        asm volatile("s_waitcnt vmcnt(0)" ::: "memory");
        __syncthreads();
        { const int rl = F.tid >> 3, ch = F.tid & 7;
#pragma unroll 2
            for (int it = 0; it < 8; ++it) att::merge_row(OG, LSE, ATT, tok0 + blk * 512 + it * 64 + rl, h, ch);
            if (unit < 128 && F.tid < 8) att::merge_row(OG, LSE, ATT, MP + (unit >> 2), unit & 3, F.tid);
        }
        __syncthreads();
    }
}

__device__ __forceinline__ void p9_final(const Frame& F, const Args& a) {
    const float* ss3 = (const float*)(a.ws + WS_SSP) + 2 * SSP_STRIDE; const f32x4* g4 = (const f32x4*)a.in[21] + F.lane;
    const int gw = F.vcu * NWAVES + F.wave, NGW = F.G * NWAVES;
    f32x4 gv[4];
#pragma unroll
    for (int j = 0; j < 4; ++j) gv[j] = g4[64 * j];
    for (int m = gw; m < MP + NS; m += NGW) {
        const float* src = (m < MP) ? a.out + O_YP + (size_t)m * DM : (const float*)(a.ws + WS_XS) + (size_t)(m - MP) * DM;
        float* dst = (m < MP) ? a.out + O_YP + (size_t)m * DM : a.out + O_YS + (size_t)(m - MP) * DM;
        const float qp = (m < MP) ? (F.lane < 16 ? ss3[(size_t)F.lane * MT + m] : 0.f) : ((const float*)(a.ws + WS_SSS))[(2 * 64 + F.lane) * 32 + (m - MP)];
        const float rs = 1.0f / sqrtf(wave_sum(qp) * (1.0f / DM) + RMS_EPS);
        const f32x4* s4 = (const f32x4*)src + F.lane; f32x4* d4 = (f32x4*)dst + F.lane;
        f32x4 v[4];
#pragma unroll
        for (int j = 0; j < 4; ++j) v[j] = s4[64 * j];
#pragma unroll
        for (int j = 0; j < 4; ++j) d4[64 * j] = v[j] * rs * gv[j];
    }
}

constexpr int N_PHASES = 10;
__global__ void __launch_bounds__(NWAVES * 64, 2) hybrid_fwd(Args args) {
    extern __shared__ __attribute__((aligned(16))) unsigned char lds[];
    Frame F;
    F.lds = (LAS unsigned char*)lds;
    F.tid = threadIdx.x; F.lane = F.tid & 63; F.wave = __builtin_amdgcn_readfirstlane(F.tid >> 6);
    F.G = gridDim.x; { const int bx = blockIdx.x; F.vcu = (F.G % 8 == 0) ? (bx % 8) * (F.G / 8) + bx / 8 : bx; }
    unsigned char* ws = args.ws;
    gu32* ctl = (gu32*)(ws + WS_CTL);
    for (int u = F.tid; u < (LDS_BYTES - LDSCTL_OFF) / 4; u += NWAVES * 64) ((LAS unsigned*)(F.lds + LDSCTL_OFF))[u] = 0u;
    __syncthreads();
    XcdBarrier bar; bar.bar = (unsigned*)(ctl + CW_BAR); bar.x = 0; bar.st = nullptr;
    const int lo = args.ph_lo, hi = args.ph_hi;
    if (hi - lo > 1) bar = xcd_barrier_post((unsigned*)(ctl + CW_BAR), (volatile LAS unsigned*)(F.lds + MISC_OFF) + 8);
#define IN(k) (lo <= (k) && (k) < hi)
#define SEAM(k) do { if (IN(k) && IN((k) + 1)) xcd_barrier(bar); } while (0)
    float* ss0 = (float*)(ws + WS_CTL) + CW_SS; float* ssp = (float*)(ws + WS_SSP);
    bf16_t* XB = (bf16_t*)(ws + WS_XB); bf16_t* H = (bf16_t*)(ws + WS_H); float* XS = (float*)(ws + WS_XS);
    float* sss = (float*)(ws + WS_SSS);
    float* XRES = args.out + O_YP;

    if (IN(0)) { p0_prologue(F, args); } SEAM(0);
#ifdef DIAG_DUMP_W
    if (IN(0) && !IN(1)) { xcd_barrier(bar);
        const size_t gt = (size_t)F.vcu * 512 + F.tid, NT = (size_t)F.G * 512; const bf16_t* Wd = (const bf16_t*)(ws + WS_W1UP); float* y = args.out + O_YP;
        for (size_t i = gt; i < (WS_XS - WS_W1UP) / 2; i += NT) y[i] = bf2f(Wd[i]); }
#endif

    if (IN(1)) {
        sk_up(F, XB, (const bf16_t*)(ws + WS_W1UP), H, ss0, nullptr);
        pg8::Gemm g{XB, (const bf16_t*)(ws + WS_W1UP), MP, 2 * FF, DM, (size_t)128 * DM, (size_t)FF * DM}; pg8::StaticOrder S; S.init(MP, 2 * FF, F.G, (int)blockIdx.x);
        EpiUp<1> E{H, ss0};
        pg8::gemm_phase<EpiUp<1>, pg8::StaticOrder, true, true>(F.lds + RING_OFF, g, S, E);
    } SEAM(1);
    if (IN(2)) {
        sk_res<4>(F, H + (size_t)MP * FF, FF, (const bf16_t*)(ws + WS_W1DN), XS, XB + (size_t)MP * DM, sss, 0.5f);
        pg8::Gemm g{H, (const bf16_t*)(ws + WS_W1DN), MP, DM, FF, (size_t)256 * FF, (size_t)128 * FF}; pg8::StaticOrder S; S.init(MP, DM, F.G, (int)blockIdx.x);
        EpiRes E{args.in[0], XRES, XB, ssp, 0.5f};
        pg8::gemm_phase<EpiRes, pg8::StaticOrder, true, true>(F.lds + RING_OFF, g, S, E);
    } SEAM(2);
    if (IN(3)) {
        sk_in(F, XB, (const bf16_t*)(ws + WS_WIN), sss, (bf16_t*)(ws + WS_U), (bf16_t*)(ws + WS_QKV), (bf16_t*)(ws + WS_G), args.out);
        pg8::Gemm g{XB, (const bf16_t*)(ws + WS_WIN), MP, INW, DM, (size_t)256 * DM, (size_t)128 * DM}; pg8::StaticOrder S; S.init(MP, INW, F.G, (int)blockIdx.x);
        EpiIn E{ssp, (bf16_t*)(ws + WS_U), (bf16_t*)(ws + WS_QKV), (bf16_t*)(ws + WS_G), args.out};
        pg8::gemm_phase<EpiIn, pg8::StaticOrder, true, true>(F.lds + RING_OFF, g, S, E);
    } SEAM(3);
    if (IN(4)) { p4_mixers(F, args); } SEAM(4);
#ifdef DIAG_DUMP_P4
    if (IN(4) && !IN(5)) { xcd_barrier(bar);
        const size_t gt = (size_t)F.vcu * 512 + F.tid, NT = (size_t)F.G * 512; const bf16_t* ATTd = (const bf16_t*)(ws + WS_ATT); const bf16_t* Pd = (const bf16_t*)(ws + WS_P); float* y = args.out + O_YP;
        for (size_t i = gt; i < (size_t)(MP + NS) * AW; i += NT) y[i] = bf2f(ATTd[i]);
        for (size_t i = gt; i < (size_t)(MP + NS) * PW; i += NT) y[(size_t)(MP + NS) * AW + i] = bf2f(Pd[i]); }
#endif
    if (IN(5)) {
        sk_br(F, (const bf16_t*)(ws + WS_P), (const bf16_t*)(ws + WS_ATT), (const bf16_t*)(ws + WS_WCOMB), (const bf16_t*)(ws + WS_WAB), (const bf16_t*)(ws + WS_G), (bf16_t*)(ws + WS_MG));
        { pg8::Gemm g{(const bf16_t*)(ws + WS_P), (const bf16_t*)(ws + WS_WCOMB), MP, DM, PW, (size_t)256 * PW, (size_t)128 * PW}; pg8::StaticOrder S; S.init(MP, DM, F.G, (int)blockIdx.x);
          EpiBr<0> E{(const bf16_t*)(ws + WS_G), (bf16_t*)(ws + WS_T1), (bf16_t*)(ws + WS_MG)};
          pg8::gemm_phase<EpiBr<0>, pg8::StaticOrder, true, true>(F.lds + RING_OFF, g, S, E); }
        asm volatile("s_waitcnt vmcnt(0)" ::: "memory"); __syncthreads();
        { pg8::Gemm g{(const bf16_t*)(ws + WS_ATT), (const bf16_t*)(ws + WS_WAB), MP, DM, AW, (size_t)256 * AW, (size_t)128 * AW}; pg8::StaticOrder S; S.init(MP, DM, F.G, (int)blockIdx.x);
          EpiBr<1> E{(const bf16_t*)(ws + WS_G), (bf16_t*)(ws + WS_T1), (bf16_t*)(ws + WS_MG)};
          pg8::gemm_phase<EpiBr<1>, pg8::StaticOrder, true, true>(F.lds + RING_OFF, g, S, E); }
    } SEAM(5);
#ifdef DIAG_DUMP
    if (IN(DIAG_STOP - 1) && !IN(DIAG_STOP)) { xcd_barrier(bar);
        const size_t gt = (size_t)F.vcu * 512 + F.tid, NT = (size_t)F.G * 512; const bf16_t* MGd = (const bf16_t*)(ws + DIAG_DUMP_OFF); float* y = args.out + O_YP;
        for (size_t i = gt; i < (size_t)MP * DM; i += NT) y[i] = bf2f(MGd[i]); }
#endif
    if (IN(6)) {
        sk_res<2>(F, (const bf16_t*)(ws + WS_MG) + (size_t)MP * DM, DM, (const bf16_t*)(ws + WS_WO), XS, XB + (size_t)MP * DM, sss + 64 * 32, 1.0f);
        pg8::Gemm g{(const bf16_t*)(ws + WS_MG), (const bf16_t*)(ws + WS_WO), MP, DM, DM, (size_t)256 * DM, (size_t)128 * DM}; pg8::StaticOrder S; S.init(MP, DM, F.G, (int)blockIdx.x);
        EpiRes E{XRES, XRES, XB, ssp + SSP_STRIDE, 1.0f};
        pg8::gemm_phase<EpiRes, pg8::StaticOrder, true, true>(F.lds + RING_OFF, g, S, E);
    } SEAM(6);
    if (IN(7)) {
        sk_up(F, XB, (const bf16_t*)(ws + WS_W2UP), H, nullptr, sss + 64 * 32);
        pg8::Gemm g{XB, (const bf16_t*)(ws + WS_W2UP), MP, 2 * FF, DM, (size_t)128 * DM, (size_t)FF * DM}; pg8::StaticOrder S; S.init(MP, 2 * FF, F.G, (int)blockIdx.x);
        EpiUp<16> E{H, ssp + SSP_STRIDE};
        pg8::gemm_phase<EpiUp<16>, pg8::StaticOrder, true, true>(F.lds + RING_OFF, g, S, E);
    } SEAM(7);
    if (IN(8)) {
        sk_res<4>(F, H + (size_t)MP * FF, FF, (const bf16_t*)(ws + WS_W2DN), XS, nullptr, sss + 2 * 64 * 32, 0.5f);
        pg8::Gemm g{H, (const bf16_t*)(ws + WS_W2DN), MP, DM, FF, (size_t)256 * FF, (size_t)128 * FF}; pg8::StaticOrder S; S.init(MP, DM, F.G, (int)blockIdx.x);
        EpiRes E{XRES, XRES, nullptr, ssp + 2 * SSP_STRIDE, 0.5f};
        pg8::gemm_phase<EpiRes, pg8::StaticOrder, true, true>(F.lds + RING_OFF, g, S, E);
    } SEAM(8);
    if (IN(9)) { p9_final(F, args); }
#undef IN
#undef SEAM
}

extern "C" void kernel_launch(void* const* d_in, const int* in_sizes, int n_in, void* d_out, int out_size, void* d_ws, size_t ws_size, hipStream_t stream) {
    static int grid = 0;
    if (grid == 0) {
        if (n_in != 22 || in_sizes[0] != MP * DM || (size_t)out_size != O_END || ws_size < WS_END) {
            fprintf(stderr, "kernel_launch: unexpected shapes (n_in %d, in0 %d, out %d, ws %zu need %zu); nothing launched\n", n_in, n_in > 0 ? in_sizes[0] : -1, out_size, ws_size, (size_t)WS_END); grid = -1; return; }
        int dev = 0, cus = 0, per_cu = 0;
        if (hipGetDevice(&dev) != hipSuccess || hipDeviceGetAttribute(&cus, hipDeviceAttributeMultiprocessorCount, dev) != hipSuccess) { grid = -1; return; }
        if (hipFuncSetAttribute((const void*)hybrid_fwd, hipFuncAttributeMaxDynamicSharedMemorySize, LDS_BYTES) != hipSuccess) { fprintf(stderr, "kernel_launch: hipFuncSetAttribute failed\n"); grid = -1; return; }
        if (hipOccupancyMaxActiveBlocksPerMultiprocessor(&per_cu, (const void*)hybrid_fwd, NWAVES * 64, LDS_BYTES) != hipSuccess || per_cu < 1) {
            fprintf(stderr, "kernel_launch: occupancy query reports %d workgroups per CU\n", per_cu); per_cu = 1; }
        (void)hipGetLastError();
        grid = cus;
    }
    if (grid < 0) return;
#ifdef DIAG_POISON
    (void)hipMemsetAsync((char*)d_ws, 0xAA, WS_END, stream); (void)hipMemsetAsync((char*)d_out, 0xAA, O_END * 4, stream);
#endif
    if (hipMemsetAsync((char*)d_ws + WS_CTL, 0, CTL_ZERO_BYTES, stream) != hipSuccess) { fprintf(stderr, "kernel_launch: memset failed\n"); return; }
    Args a{};
    for (int i = 0; i < 22; ++i) a.in[i] = (const float*)d_in[i];
    a.out = (float*)d_out; a.ws = (unsigned char*)d_ws;
    constexpr int NL = MK_N_LAUNCHES;
    for (int li = 0; li < NL; ++li) {
        a.ph_lo = (NL == 1) ? 0 : li; a.ph_hi = (NL == 1) ? N_PHASES : li + 1;
#ifdef DIAG_STOP
        a.ph_hi = DIAG_STOP;
#endif
        hipLaunchKernelGGL(hybrid_fwd, dim3(grid), dim3(NWAVES * 64), LDS_BYTES, stream, a);
        const hipError_t le = hipPeekAtLastError();
        if (le != hipSuccess) { fprintf(stderr, "kernel_launch: launch %d failed: %s\n", li, hipGetErrorName(le)); break; }
    }
}
```

```cpp
#include <hip/hip_runtime.h>
#include <cstdio>
#include <cstdint>

#ifndef DIAG_REPEAT
#define DIAG_REPEAT -1
#endif
#define TWICE(k, ...) do { __VA_ARGS__; if (DIAG_REPEAT == (k)) { xcd_barrier(bar); __VA_ARGS__; } } while (0)
#ifndef MK_N_LAUNCHES
#define MK_N_LAUNCHES 1
#endif

constexpr int DM = 1024, NB = 16, SEQ = 2048, NS = 32, PAST = 16384, FF = 2816, INW = 4864;
constexpr int MP = NB * SEQ;
constexpr int MT = MP + 256;
constexpr int QKVW = 2304, PW = 512, GW = 2048, AW = 256;
constexpr float RMS_EPS = 1e-6f;
constexpr float C2 = 0.125f * 1.4426950408889634f;

constexpr size_t O_YP = 0, O_YS = 33554432, O_POOLP = 33587200, O_KV128P = 33710080, O_KV512P = 34758656, O_KV2048P = 38952960,
                 O_POOLS = 55730176, O_KV128S = 55975936, O_KV512S = 58073088, O_KV2048S = 66461696, O_END = 100016128;

namespace pg8 {
#define PG8_LAS __attribute__((address_space(3)))
typedef unsigned short bf16_t;
typedef short bf16x8 __attribute__((ext_vector_type(8)));
typedef float f32x4 __attribute__((ext_vector_type(4)));
typedef float f32x2 __attribute__((ext_vector_type(2)));
typedef unsigned u32x4 __attribute__((ext_vector_type(4)));
typedef unsigned u32x2 __attribute__((ext_vector_type(2)));
constexpr int BM = 256, BK = 64, HALF = 128, HTB = HALF * BK * 2, STAGE_BYTES = 8 * HTB, NXCD = 8, WGM = 8;

__host__ __device__ __forceinline__ int lds_byte(int r, int c) { const int st = (r >> 4) * 2 + (c >> 5), rr = r & 15, cc = c & 31, ob = rr * 64 + cc * 2; return st * 1024 + (ob ^ (((ob >> 9) & 1) << 5)); }
__host__ __device__ __forceinline__ void stage_rc(int b, int& R, int& C) { const int st = b / 1024, sb = b % 1024, swz = sb ^ (((sb >> 9) & 1) << 5); R = (st >> 1) * 16 + swz / 64; C = (st & 1) * 32 + (swz % 64) / 2; }
__host__ __device__ __forceinline__ int perm32(int rho) { const int n = rho >> 4, i = rho & 15; return 8 * (i >> 2) + 4 * n + (i & 3); }

struct Unit { int pm, pn; };
struct Gemm { const bf16_t* A; const bf16_t* Bt; int M, N, K; size_t b_tile, b_half; };

struct StaticOrder {
    int nM, nN, nwg, G, c;
    __host__ __device__ void init(int M, int N, int G_, int c_) { nM = M / BM; nN = N / BM; nwg = nM * nN; G = G_; c = c_; }
    __host__ __device__ bool next(int i, Unit& u) const {
        const long L = (long)i * G + c; if (L >= nwg) return false;
        int wgid = (int)L; { const int q = nwg / NXCD, r = nwg % NXCD, xcd = wgid % NXCD, off = wgid / NXCD; wgid = (xcd < r ? xcd * (q + 1) : r * (q + 1) + (xcd - r) * q) + off; }
        const int nig = WGM * nN, gid = wgid / nig, fm = gid * WGM, gsz = (nM - fm) < WGM ? (nM - fm) : WGM;
        u.pm = fm + ((wgid % nig) % gsz); u.pn = (wgid % nig) / gsz; return true;
    }
};

typedef __bf16 bf16x2_t __attribute__((ext_vector_type(2)));
__device__ __forceinline__ unsigned cvt_pk_bf16(float lo, float hi) { const f32x2 v = {lo, hi}; const bf16x2_t b = __builtin_convertvector(v, bf16x2_t); return __builtin_bit_cast(unsigned, b); }

template <class Epi, class Sched, bool ALIGN_EPI = false, bool SP2 = false>
__device__ __forceinline__ void gemm_phase(PG8_LAS unsigned char* lds, const Gemm g, const Sched& S, const Epi& E) {
    const int tid = threadIdx.x, wid = __builtin_amdgcn_readfirstlane(tid >> 6), lane = tid & 63, wr = wid >> 2, wc = wid & 3, fr = lane & 15, fq = lane >> 4;
    const int K = g.K, nt = K / BK;
    unsigned voffA[2], voffB[2];
#pragma unroll
    for (int i = 0; i < 2; ++i) { int R, C; stage_rc(tid * 16 + i * 8192, R, C); int Rb = R;
        if constexpr (Epi::PERM == 1) Rb = (R & ~31) + perm32(R & 31);
        if constexpr (Epi::PERM == 2) Rb = (R & ~48) | (((R >> 4) & 1) << 5) | (((R >> 5) & 1) << 4);
        voffA[i] = (unsigned)(R * K + C) * 2u; voffB[i] = (unsigned)(Rb * K + C) * 2u; }
    const size_t kstep = (size_t)(BK * 2);
    const size_t hstep = (size_t)HALF * K * 2;
    const size_t tstep = 2 * hstep;
    const size_t bhstep = g.b_half * 2, btstep = g.b_tile * 2;
    const unsigned ldsw = (unsigned)wid * 1024u;
    const int aoff = lds_byte(wr * 64 + fr, fq * 8), boff = lds_byte(wc * 32 + fr, fq * 8);
#define PG8_SA(b, h) (((b) * 2 + (h)) * HTB)
#define PG8_SB(b, h) ((4 + (b) * 2 + (h)) * HTB)
#define PG8_STAGE(bufoff, gbase, voff) do { _Pragma("unroll") for (int _i = 0; _i < 2; ++_i) \
        __builtin_amdgcn_global_load_lds((const unsigned*)((const char*)(gbase) + (voff)[_i]), (PG8_LAS unsigned*)(lds + (bufoff) + ldsw + _i * 8192), 16, 0, 0); } while (0)
#define PG8_LDA(dst, b, h) do { _Pragma("unroll") for (int m = 0; m < 4; ++m) _Pragma("unroll") for (int k = 0; k < 2; ++k) dst[m][k] = *(const PG8_LAS bf16x8*)(lds + PG8_SA(b, h) + aoff + m * 2048 + k * 1024); } while (0)
#define PG8_LDB(dst, b, h) do { _Pragma("unroll") for (int n = 0; n < 2; ++n) _Pragma("unroll") for (int k = 0; k < 2; ++k) dst[n][k] = *(const PG8_LAS bf16x8*)(lds + PG8_SB(b, h) + boff + n * 2048 + k * 1024); } while (0)
#define PG8_MMA(ai, bj, At, Bt) do { __builtin_amdgcn_s_setprio(1); _Pragma("unroll") for (int m = 0; m < 4; ++m) _Pragma("unroll") for (int n = 0; n < 2; ++n) _Pragma("unroll") for (int k = 0; k < 2; ++k) \
        acc[ai][bj][m][n] = __builtin_amdgcn_mfma_f32_16x16x32_bf16(Bt[n][k], At[m][k], acc[ai][bj][m][n], 0, 0, 0); __builtin_amdgcn_s_setprio(0); } while (0)
#define PG8_WAIT_V(n) asm volatile("s_waitcnt vmcnt(" #n ")" ::: "memory")
#define PG8_WAIT_L(n) asm volatile("s_waitcnt lgkmcnt(" #n ")" ::: "memory")
#define PG8_BAR __builtin_amdgcn_s_barrier()
#define PG8_SCHED __builtin_amdgcn_sched_barrier(0)
    Unit cur, nxt; int ui = 0;
    if (!S.next(0, cur)) return;
    f32x4 acc[2][2][4][2];
#pragma unroll
    for (int a = 0; a < 2; ++a)
#pragma unroll
        for (int b = 0; b < 2; ++b)
#pragma unroll
            for (int m = 0; m < 4; ++m)
#pragma unroll
                for (int n = 0; n < 2; ++n) acc[a][b][m][n] = (f32x4){0.f, 0.f, 0.f, 0.f};
    bf16x8 At[4][2], B0[2][2], B1[2][2];
    const char* cA = (const char*)g.A + (size_t)cur.pm * tstep; const char* cB = (const char*)g.Bt + (size_t)cur.pn * btstep;
    if constexpr (SP2) {
        PG8_STAGE(PG8_SB(0, 0), cB, voffB); PG8_STAGE(PG8_SB(0, 1), cB + bhstep, voffB); PG8_STAGE(PG8_SA(0, 0), cA, voffA); PG8_STAGE(PG8_SA(0, 1), cA + hstep, voffA);
        if (wr == 1) PG8_BAR;
        PG8_WAIT_V(2); PG8_BAR;
        PG8_STAGE(PG8_SB(1, 0), cB + kstep, voffB); PG8_STAGE(PG8_SA(1, 0), cA + kstep, voffA); PG8_STAGE(PG8_SB(1, 1), cB + bhstep + kstep, voffB);
        PG8_WAIT_V(6); PG8_BAR;
    } else {
        PG8_STAGE(PG8_SB(0, 0), cB, voffB); PG8_STAGE(PG8_SA(0, 0), cA, voffA); PG8_STAGE(PG8_SB(0, 1), cB + bhstep, voffB); PG8_STAGE(PG8_SA(0, 1), cA + hstep, voffA);
        if (wr == 1) PG8_BAR;
        PG8_WAIT_V(4); PG8_BAR;
        PG8_STAGE(PG8_SB(1, 0), cB + kstep, voffB); PG8_STAGE(PG8_SA(1, 0), cA + kstep, voffA); PG8_STAGE(PG8_SB(1, 1), cB + bhstep + kstep, voffB);
        PG8_WAIT_V(6); PG8_BAR;
    }
    for (;;) {
        const bool has_next = S.next(ui + 1, nxt);
        const char* nA = has_next ? (const char*)g.A + (size_t)nxt.pm * tstep : cA; const char* nB = has_next ? (const char*)g.Bt + (size_t)nxt.pn * btstep : cB;
        for (int t = 0; t < nt; t += 2) {
            const bool last = (t == nt - 2);
            const char* a1 = cA + (size_t)(t + 1) * kstep;
            const char* a2 = last ? nA : cA + (size_t)(t + 2) * kstep; const char* b2 = last ? nB : cB + (size_t)(t + 2) * kstep;
            const char* a3 = a2 + kstep; const char* b3 = b2 + kstep;
            if constexpr (SP2) {
            PG8_LDB(B0, 0, 0); PG8_LDB(B1, 0, 1); PG8_SCHED; PG8_LDA(At, 0, 0); PG8_STAGE(PG8_SA(1, 1), a1 + hstep, voffA);
            PG8_WAIT_V(8); PG8_WAIT_L(0); PG8_BAR; PG8_MMA(0, 0, At, B0); PG8_MMA(0, 1, At, B1); PG8_BAR; PG8_SCHED;
            PG8_LDA(At, 0, 1); PG8_STAGE(PG8_SB(0, 0), b2, voffB); PG8_STAGE(PG8_SB(0, 1), b2 + bhstep, voffB); PG8_STAGE(PG8_SA(0, 0), a2, voffA);
            PG8_WAIT_V(8); PG8_WAIT_L(0); PG8_BAR; PG8_MMA(1, 0, At, B0); PG8_MMA(1, 1, At, B1); PG8_BAR; PG8_SCHED;
            PG8_LDB(B0, 1, 0); PG8_LDB(B1, 1, 1); PG8_SCHED; PG8_LDA(At, 1, 0); PG8_STAGE(PG8_SA(0, 1), a2 + hstep, voffA);
            PG8_WAIT_V(8); PG8_WAIT_L(0); PG8_BAR; PG8_MMA(0, 0, At, B0); PG8_MMA(0, 1, At, B1); PG8_BAR; PG8_SCHED;
            PG8_LDA(At, 1, 1); PG8_STAGE(PG8_SB(1, 0), b3, voffB); PG8_STAGE(PG8_SB(1, 1), b3 + bhstep, voffB); PG8_STAGE(PG8_SA(1, 0), a3, voffA);
            PG8_WAIT_V(8); PG8_WAIT_L(0); PG8_BAR; PG8_MMA(1, 0, At, B0); PG8_MMA(1, 1, At, B1); PG8_BAR; PG8_SCHED;
            } else {
            PG8_LDB(B0, 0, 0); PG8_SCHED; PG8_LDA(At, 0, 0); PG8_STAGE(PG8_SA(1, 1), a1 + hstep, voffA);
            PG8_WAIT_L(8); PG8_BAR; PG8_WAIT_L(0); PG8_MMA(0, 0, At, B0); PG8_BAR; PG8_SCHED;
            PG8_LDB(B1, 0, 1); PG8_STAGE(PG8_SB(0, 0), b2, voffB);
            PG8_BAR; PG8_WAIT_L(0); PG8_MMA(0, 1, At, B1); PG8_BAR;
            PG8_LDA(At, 0, 1); PG8_STAGE(PG8_SA(0, 0), a2, voffA);
            PG8_BAR; PG8_WAIT_L(0); PG8_MMA(1, 0, At, B0); PG8_BAR; PG8_SCHED;
            PG8_STAGE(PG8_SB(0, 1), b2 + bhstep, voffB);
            PG8_WAIT_V(6); PG8_BAR; PG8_MMA(1, 1, At, B1); PG8_BAR;
            PG8_LDB(B0, 1, 0); PG8_SCHED; PG8_LDA(At, 1, 0); PG8_STAGE(PG8_SA(0, 1), a2 + hstep, voffA);
            PG8_WAIT_L(8); PG8_BAR; PG8_WAIT_L(0); PG8_MMA(0, 0, At, B0); PG8_BAR; PG8_SCHED;
            PG8_LDB(B1, 1, 1); PG8_STAGE(PG8_SB(1, 0), b3, voffB);
            PG8_BAR; PG8_WAIT_L(0); PG8_MMA(0, 1, At, B1); PG8_BAR;
            PG8_LDA(At, 1, 1); PG8_STAGE(PG8_SA(1, 0), a3, voffA);
            PG8_BAR; PG8_WAIT_L(0); PG8_MMA(1, 0, At, B0); PG8_BAR; PG8_SCHED;
            PG8_STAGE(PG8_SB(1, 1), b3 + bhstep, voffB);
            PG8_WAIT_V(6); PG8_BAR; PG8_MMA(1, 1, At, B1); PG8_BAR;
            }
        }
        if constexpr (ALIGN_EPI) { if (wr == 0) PG8_BAR; }
        E(acc, cur, wr, wc, fr, fq);
        if (!has_next) break;
#pragma unroll
        for (int a = 0; a < 2; ++a)
#pragma unroll
            for (int b = 0; b < 2; ++b)
#pragma unroll
                for (int m = 0; m < 4; ++m)
#pragma unroll
                    for (int n = 0; n < 2; ++n) acc[a][b][m][n] = (f32x4){0.f, 0.f, 0.f, 0.f};
        cur = nxt; cA = nA; cB = nB; ++ui;
        if constexpr (ALIGN_EPI) { if (wr == 1) PG8_BAR; }
    }
    PG8_WAIT_V(0);
    if constexpr (!ALIGN_EPI) { if (wr == 0) PG8_BAR; }
    PG8_BAR;
#undef PG8_SA
#undef PG8_SB
#undef PG8_STAGE
#undef PG8_LDA
#undef PG8_LDB
#undef PG8_MMA
#undef PG8_WAIT_V
#undef PG8_WAIT_L
#undef PG8_BAR
#undef PG8_SCHED
}
}

using pg8::bf16_t; using pg8::f32x4; using pg8::u32x4; using pg8::u32x2; using pg8::bf16x8; using pg8::cvt_pk_bf16; using pg8::Unit;
typedef float f32x16 __attribute__((ext_vector_type(16)));
typedef short s16x4 __attribute__((ext_vector_type(4)));

#define GAS __attribute__((address_space(1)))
#define LAS __attribute__((address_space(3)))
typedef GAS unsigned gu32;
#define RLX_AGENT __ATOMIC_RELAXED, __HIP_MEMORY_SCOPE_AGENT

__device__ __forceinline__ float bf2f(unsigned short h) { return __uint_as_float((unsigned)h << 16); }
__device__ __forceinline__ float bflo(unsigned w) { return __uint_as_float(w << 16); }
__device__ __forceinline__ float bfhi(unsigned w) { return __uint_as_float(w & 0xffff0000u); }
__device__ __forceinline__ u32x2 pack4(f32x4 v) { u32x2 w; w.x = cvt_pk_bf16(v[0], v[1]); w.y = cvt_pk_bf16(v[2], v[3]); return w; }
__device__ __forceinline__ float rstd_of(const float* ss, int r) { return 1.0f / sqrtf(ss[r] * (1.0f / DM) + RMS_EPS); }
template <int NP> __device__ __forceinline__ float rstd_row(const float* ss, int r, int fq) {
    if (NP == 1) return rstd_of(ss, r);
    float q = (ss[(size_t)(4 * fq + 0) * MT + r] + ss[(size_t)(4 * fq + 1) * MT + r]) + (ss[(size_t)(4 * fq + 2) * MT + r] + ss[(size_t)(4 * fq + 3) * MT + r]);
    q += __shfl_xor(q, 16); q += __shfl_xor(q, 32);
    return 1.0f / sqrtf(q * (1.0f / DM) + RMS_EPS);
}
__device__ __forceinline__ float sigmoidf_(float v) { return __builtin_amdgcn_rcpf(1.0f + __builtin_amdgcn_exp2f(-1.4426950408889634f * v)); }

template <int NP> struct EpiUp {
    static constexpr int PERM = 1;
    bf16_t* H; const float* ss;
    __device__ __forceinline__ void operator()(const f32x4 (&acc)[2][2][4][2], const Unit& u, int wr, int wc, int fr, int fq) const {
        const int row0 = u.pm * 256 + wr * 64 + fr, col0 = u.pn * 128 + wc * 32 + 8 * fq;
#pragma unroll
        for (int ai = 0; ai < 2; ++ai)
#pragma unroll
            for (int m = 0; m < 4; ++m) {
                const int r = row0 + ai * 128 + m * 16; const float rs = rstd_row<NP>(ss, r, fq);
                f32x4 h[2];
#pragma unroll
                for (int n = 0; n < 2; ++n) { const f32x4 gt = acc[ai][0][m][n] * rs, up = acc[ai][1][m][n] * rs;
#pragma unroll
                    for (int e = 0; e < 4; ++e) h[n][e] = gt[e] * sigmoidf_(gt[e]) * up[e]; }
                u32x4 w; w.x = cvt_pk_bf16(h[0][0], h[0][1]); w.y = cvt_pk_bf16(h[0][2], h[0][3]); w.z = cvt_pk_bf16(h[1][0], h[1][1]); w.w = cvt_pk_bf16(h[1][2], h[1][3]);
                *(u32x4*)(H + (size_t)r * FF + col0) = w;
            }
    }
};

template <bool SRCF, bool DSTF> struct EpiRes {
    static constexpr int PERM = 1;
    const float* srcf; const bf16_t* srcb; float* dstf; bf16_t* dstb; float* ss_out; float scale;
    __device__ __forceinline__ void operator()(const f32x4 (&acc)[2][2][4][2], const Unit& u, int wr, int wc, int fr, int fq) const {
        const int row0 = u.pm * 256 + wr * 64 + fr, col0 = u.pn * 256 + wc * 32 + 8 * fq;
#pragma unroll
        for (int ai = 0; ai < 2; ++ai)
#pragma unroll
            for (int m = 0; m < 4; ++m) {
                const int r = row0 + ai * 128 + m * 16; float q = 0.f;
#pragma unroll
                for (int bj = 0; bj < 2; ++bj) { const size_t o = (size_t)r * DM + col0 + bj * 128; f32x4 x0, x1;
                    if (SRCF) { x0 = *(const f32x4*)(srcf + o); x1 = *(const f32x4*)(srcf + o + 4); }
                    else { const u32x4 w = *(const u32x4*)(srcb + o); x0 = (f32x4){bflo(w.x), bfhi(w.x), bflo(w.y), bfhi(w.y)}; x1 = (f32x4){bflo(w.z), bfhi(w.z), bflo(w.w), bfhi(w.w)}; }
                    const f32x4 v0 = x0 + acc[ai][bj][m][0] * scale, v1 = x1 + acc[ai][bj][m][1] * scale;
                    if (DSTF) { *(f32x4*)(dstf + o) = v0; *(f32x4*)(dstf + o + 4) = v1; }
                    else { u32x4 w; w.x = cvt_pk_bf16(v0[0], v0[1]); w.y = cvt_pk_bf16(v0[2], v0[3]); w.z = cvt_pk_bf16(v1[0], v1[1]); w.w = cvt_pk_bf16(v1[2], v1[3]); *(u32x4*)(dstb + o) = w; }
                    q += ((v0[0] * v0[0] + v0[1] * v0[1]) + (v0[2] * v0[2] + v0[3] * v0[3])) + ((v1[0] * v1[0] + v1[1] * v1[1]) + (v1[2] * v1[2] + v1[3] * v1[3])); }
                q += __shfl_xor(q, 16); q += __shfl_xor(q, 32);
                if (fq == 0) ss_out[(size_t)(u.pn * 4 + wc) * MT + r] = q;
            }
    }
};

__device__ __forceinline__ u32x4 pair16(u32x2 w0, u32x2 w1) {
    const auto rx = __builtin_amdgcn_permlane16_swap(w0.x, w1.x, false, false), ry = __builtin_amdgcn_permlane16_swap(w0.y, w1.y, false, false);
    return (u32x4){rx[0], ry[0], rx[1], ry[1]};
}

__device__ __forceinline__ void sincos_rev(float ang, float& s, float& c) {
    const float C_hi = 0.15915494f, C_lo = 6.4206383e-09f;
    const float p = ang * C_hi; float e = __builtin_fmaf(ang, C_hi, -p); e = __builtin_fmaf(ang, C_lo, e);
    const float f = __builtin_amdgcn_fractf(p) + e;
    s = __builtin_amdgcn_sinf(f); c = __builtin_amdgcn_cosf(f);
}

struct EpiIn {
    static constexpr int PERM = 2;
    const float* ss; bf16_t* U; bf16_t* QKV; bf16_t* G; float* out;
    __device__ __forceinline__ void operator()(const f32x4 (&acc)[2][2][4][2], const Unit& u, int wr, int wc, int fr, int fq) const {
        const int row0 = u.pm * 256 + wr * 64 + fr;
        const int hsel = wc >> 1, dlo = 16 * (wc & 1) + 4 * fq;
        const int cb = 64 * hsel + dlo;
        const int cst = (fq & 1) ? cb + 28 : cb;
        const int pn = u.pn;
        if (pn < 2) {
#pragma unroll
            for (int ai = 0; ai < 2; ++ai)
#pragma unroll
                for (int m = 0; m < 4; ++m) {
                    const int r = row0 + ai * 128 + m * 16; const float rs = rstd_row<16>(ss, r, fq);
                    const int t = r & (SEQ - 1), b = r >> 11; float* po = nullptr;
                    if (t >= SEQ - 15) po = out + O_POOLP + (size_t)(b * 15 + (t - (SEQ - 15))) * PW + pn * 256 + cb;
#pragma unroll
                    for (int bj = 0; bj < 2; ++bj) { const f32x4 v0 = acc[ai][bj][m][0] * rs, v1 = acc[ai][bj][m][1] * rs;
                        *(u32x4*)(U + (size_t)r * PW + pn * 256 + 128 * bj + cst) = pair16(pack4(v0), pack4(v1));
                        if (po) { *(f32x4*)(po + 128 * bj) = v0; *(f32x4*)(po + 128 * bj + 32) = v1; } }
                }
        } else if (pn < 11) {
            const int j = pn - 2, g = j / 3, which = j - 3 * g;
            float inv[4];
#pragma unroll
            for (int e = 0; e < 4; ++e) inv[e] = __builtin_amdgcn_exp2f(-(float)(dlo + e) * (13.287712379549449f / 32.0f));
#pragma unroll
            for (int ai = 0; ai < 2; ++ai)
#pragma unroll
                for (int m = 0; m < 4; ++m) {
                    const int r = row0 + ai * 128 + m * 16; const float rs = rstd_row<16>(ss, r, fq);
                    bf16_t* qrow = QKV + (size_t)r * QKVW + g * 768 + which * 256 + cst;
                    if (which == 2) {
#pragma unroll
                        for (int bj = 0; bj < 2; ++bj) *(u32x4*)(qrow + 128 * bj) = pair16(pack4(acc[ai][bj][m][0] * rs), pack4(acc[ai][bj][m][1] * rs));
                    } else {
                        const float pos = (float)(r & (SEQ - 1));
                        f32x4 cs, sn;
#pragma unroll
                        for (int e = 0; e < 4; ++e) { float s_, c_; sincos_rev(pos * inv[e], s_, c_); cs[e] = c_; sn[e] = s_; }
                        const float sc = (which == 0) ? rs * C2 : rs;
#pragma unroll
                        for (int bj = 0; bj < 2; ++bj) { const f32x4 t1 = acc[ai][bj][m][0] * sc, t2 = acc[ai][bj][m][1] * sc;
                            *(u32x4*)(qrow + 128 * bj) = pair16(pack4(t1 * cs - t2 * sn), pack4(t1 * sn + t2 * cs)); }
                    }
                }
        } else {
#pragma unroll
            for (int ai = 0; ai < 2; ++ai)
#pragma unroll
                for (int m = 0; m < 4; ++m) {
                    const int r = row0 + ai * 128 + m * 16; const float rs = rstd_row<16>(ss, r, fq);
#pragma unroll
                    for (int bj = 0; bj < 2; ++bj) { const f32x4 v0 = acc[ai][bj][m][0] * rs, v1 = acc[ai][bj][m][1] * rs; f32x4 s0, s1;
#pragma unroll
                        for (int e = 0; e < 4; ++e) { s0[e] = sigmoidf_(v0[e]); s1[e] = sigmoidf_(v1[e]); }
                        *(u32x4*)(G + (size_t)r * GW + (pn - 11) * 256 + 128 * bj + cst) = pair16(pack4(s0), pack4(s1)); }
                }
        }
    }
};

template <int SECOND> struct EpiBr {
    static constexpr int PERM = 1;
    const bf16_t* G; bf16_t* T1; bf16_t* MG;
    __device__ __forceinline__ void operator()(const f32x4 (&acc)[2][2][4][2], const Unit& u, int wr, int wc, int fr, int fq) const {
        const int row0 = u.pm * 256 + wr * 64 + fr, col0 = u.pn * 256 + wc * 32 + 8 * fq;
#pragma unroll
        for (int ai = 0; ai < 2; ++ai)
#pragma unroll
            for (int m = 0; m < 4; ++m) {
                const int r = row0 + ai * 128 + m * 16;
#pragma unroll
                for (int bj = 0; bj < 2; ++bj) { const int c = col0 + bj * 128;
                    const u32x4 gw = *(const u32x4*)(G + (size_t)r * GW + SECOND * DM + c);
                    const f32x4 a0 = acc[ai][bj][m][0], a1 = acc[ai][bj][m][1];
                    float v[8] = {a0[0] * bflo(gw.x), a0[1] * bfhi(gw.x), a0[2] * bflo(gw.y), a0[3] * bfhi(gw.y), a1[0] * bflo(gw.z), a1[1] * bfhi(gw.z), a1[2] * bflo(gw.w), a1[3] * bfhi(gw.w)};
                    if (SECOND) { const u32x4 tw = *(const u32x4*)(T1 + (size_t)r * DM + c);
                        v[0] += bflo(tw.x); v[1] += bfhi(tw.x); v[2] += bflo(tw.y); v[3] += bfhi(tw.y); v[4] += bflo(tw.z); v[5] += bfhi(tw.z); v[6] += bflo(tw.w); v[7] += bfhi(tw.w); }
                    u32x4 w; w.x = cvt_pk_bf16(v[0], v[1]); w.y = cvt_pk_bf16(v[2], v[3]); w.z = cvt_pk_bf16(v[4], v[5]); w.w = cvt_pk_bf16(v[6], v[7]);
                    *(u32x4*)((SECOND ? MG : T1) + (size_t)r * DM + c) = w; }
            }
    }
};

constexpr size_t MiB = 1u << 20;
constexpr size_t WS_CTL = 0, CTL_ZERO_BYTES = 1 * MiB;
constexpr int CW_BAR = 4096;
constexpr int CW_SS = 16384;
static_assert((CW_SS + MT) * 4 <= (int)CTL_ZERO_BYTES, "ctl");
constexpr size_t WS_W1UP = 1 * MiB;
constexpr size_t WS_W1DN = WS_W1UP + (size_t)2 * FF * DM * 2;
constexpr size_t WS_WIN = WS_W1DN + (size_t)DM * FF * 2;
constexpr size_t WS_WCOMB = WS_WIN + (size_t)INW * DM * 2;
constexpr size_t WS_WAB = WS_WCOMB + (size_t)DM * PW * 2;
constexpr size_t WS_WO = WS_WAB + (size_t)DM * AW * 2;
constexpr size_t WS_W2UP = WS_WO + (size_t)DM * DM * 2;
constexpr size_t WS_W2DN = WS_W2UP + (size_t)2 * FF * DM * 2;
constexpr size_t WS_XS = WS_W2DN + (size_t)DM * FF * 2;
constexpr size_t WS_XB = WS_XS + (size_t)256 * DM * 4;
constexpr size_t OG_BYTES = (size_t)MT * 768 * 2, LSE_BYTES = (size_t)MT * 12 * 4;
static_assert(OG_BYTES + LSE_BYTES <= (size_t)MP * DM * 4, "OG/LSE fit in the y_prompt region");
constexpr size_t WS_Z = WS_XB + (size_t)MT * DM * 2;
constexpr size_t WS_H = WS_Z;
constexpr size_t WS_U = WS_Z;
constexpr size_t WS_QKV = WS_U + (size_t)MT * PW * 2;
constexpr size_t WS_T1 = WS_QKV, WS_MG = WS_QKV + (size_t)MT * DM * 2;
constexpr size_t WS_G = WS_QKV + (size_t)MT * QKVW * 2;
static_assert(WS_MG + (size_t)MT * DM * 2 <= WS_G, "T1/MG overlay fits in QKV");
constexpr size_t WS_P = WS_G + (size_t)MT * GW * 2;
static_assert(WS_H + (size_t)MT * FF * 2 <= WS_P, "H overlay fits in Z");
constexpr size_t WS_ATT = WS_P + (size_t)MT * PW * 2;
constexpr size_t WS_SSP = WS_ATT + (size_t)MT * AW * 2;
constexpr size_t SSP_STRIDE = (size_t)16 * MT;
constexpr size_t WS_SSS = WS_SSP + 3 * SSP_STRIDE * 4;
constexpr size_t WS_END = WS_SSS + 3 * 64 * 32 * 4;

constexpr int RING_OFF = 0, RING_BYTES = 131072;
constexpr int LDSCTL_OFF = RING_BYTES, MISC_OFF = LDSCTL_OFF + 320;
constexpr int LDS_BYTES = 147456;
constexpr int NWAVES = 8;

#define XB_TMO      128
#define XB_XCNT(j)  (256  + 64 * (j))
#define XB_XSUB(j)  (1280 + 64 * (j))
#define XB_XGEN(j)  (2304 + 64 * (j))
#define XB_TOP      3328
#define XB_TOPGEN   3392
#define XCD_BAR_WORDS 3456
#define XB_SPIN_CAP (1u << 18)
__device__ __forceinline__ unsigned xb_ld(unsigned* p)              { return __hip_atomic_load(p, __ATOMIC_RELAXED, __HIP_MEMORY_SCOPE_AGENT); }
__device__ __forceinline__ unsigned xb_add(unsigned* p, unsigned v) { return __hip_atomic_fetch_add(p, v, __ATOMIC_RELAXED, __HIP_MEMORY_SCOPE_AGENT); }
__device__ __forceinline__ unsigned xb_xcc_id() { return (unsigned)__builtin_amdgcn_s_getreg((3 << 11) | 20) & 0xFu; }
#define XB_SPIN(cond, bar) do { unsigned _sp = 0; while (cond) { __builtin_amdgcn_s_sleep(1); \
    if ((++_sp & 255u) == 0u) { if (xb_ld(&(bar)[XB_TMO])) break; if (_sp > XB_SPIN_CAP) { atomicAdd(&(bar)[XB_TMO], 1u); break; } } } } while (0)
struct XcdBarrier { unsigned* bar; unsigned x; volatile LAS unsigned* st; };
__device__ __forceinline__ XcdBarrier xcd_barrier_post(unsigned* bar, volatile LAS unsigned* st) {
    XcdBarrier b; b.bar = bar; b.x = xb_xcc_id(); b.st = st;
    if (threadIdx.x == 0) (void)xb_add(&bar[XB_XCNT(b.x)], 1u);
    return b;
}
__device__ __forceinline__ void xcd_barrier_complete(unsigned* bar, unsigned x, unsigned& nloc, unsigned& nx) {
    const unsigned G = gridDim.x * gridDim.y * gridDim.z;
    unsigned sum, cnt, mine, sp = 0u;
    for (;;) {
        sum = 0u; cnt = 0u; mine = 0u;
#pragma unroll
        for (unsigned j = 0; j < 16; ++j) { const unsigned c = xb_ld(&bar[XB_XCNT(j)]); sum += c; cnt += (c > 0u) ? 1u : 0u; mine = (j == x) ? c : mine; }
        if (sum == G) break;
        __builtin_amdgcn_s_sleep(1);
        if ((++sp & 255u) == 0u) { if (xb_ld(&bar[XB_TMO])) break; if (sp > XB_SPIN_CAP) { atomicAdd(&bar[XB_TMO], 1u); break; } }
    }
    nloc = mine > 0u ? mine : 1u; nx = cnt > 0u ? cnt : 1u;
}
__device__ __forceinline__ void xcd_barrier(const XcdBarrier& b) {
    asm volatile("s_waitcnt vmcnt(0)" ::: "memory");
    __syncthreads();
    if (threadIdx.x == 0) {
        unsigned* bar = b.bar;
        __builtin_amdgcn_s_waitcnt(0);
        unsigned nloc = b.st[0], nx = b.st[1];
        if (nloc == 0u) { xcd_barrier_complete(bar, b.x, nloc, nx); b.st[0] = nloc; b.st[1] = nx; }
        const unsigned old = xb_add(&bar[XB_XSUB(b.x)], 1u);
        const unsigned gen = old / nloc;
        if (old + 1u == (gen + 1u) * nloc) {
            __builtin_amdgcn_fence(__ATOMIC_RELEASE, "agent");
            asm volatile("s_waitcnt vmcnt(0)" ::: "memory");
            const unsigned og = xb_add(&bar[XB_TOP], 1u);
            const unsigned tg = og / nx;
            if (og + 1u == (tg + 1u) * nx) xb_add(&bar[XB_TOPGEN], 1u);
            else XB_SPIN(xb_ld(&bar[XB_TOPGEN]) == tg, bar);
            __builtin_amdgcn_fence(__ATOMIC_ACQUIRE, "agent");
            xb_add(&bar[XB_XGEN(b.x)], 1u);
            asm volatile("s_waitcnt vmcnt(0)" ::: "memory");
        } else {
            XB_SPIN(xb_ld(&bar[XB_XGEN(b.x)]) == gen, bar);
            __builtin_amdgcn_fence(__ATOMIC_ACQUIRE, "agent");
            asm volatile("s_waitcnt vmcnt(0)" ::: "memory");
        }
    }
    __syncthreads();
}

struct Args { const float* in[22]; float* out; unsigned char* ws; int ph_lo, ph_hi; };
struct Frame {
    LAS unsigned char* lds; int tid, lane, wave, vcu, G;
};
#define LDS_WAIT() asm volatile("s_waitcnt lgkmcnt(0)" ::: "memory")


template <int NF> __device__ __forceinline__ void sk_mma(const bf16_t* A, int lda, const bf16_t* const (&Bp)[NF], int ldb, int k0, int k1, f32x4 (&acc)[2][NF], int lane) {
    const int fr = lane & 15, fq = lane >> 4;
    const bf16_t* a0 = A + (size_t)fr * lda + 8 * fq; const bf16_t* a1 = a0 + (size_t)16 * lda;
    const bf16_t* b[NF];
#pragma unroll
    for (int n = 0; n < NF; ++n) b[n] = Bp[n] + (size_t)fr * ldb + 8 * fq;
#pragma unroll 4
    for (int k = k0; k < k1; k += 32) {
        const bf16x8 av0 = *(const bf16x8*)(a0 + k), av1 = *(const bf16x8*)(a1 + k);
#pragma unroll
        for (int n = 0; n < NF; ++n) { const bf16x8 bv = *(const bf16x8*)(b[n] + k);
            acc[0][n] = __builtin_amdgcn_mfma_f32_16x16x32_bf16(bv, av0, acc[0][n], 0, 0, 0);
            acc[1][n] = __builtin_amdgcn_mfma_f32_16x16x32_bf16(bv, av1, acc[1][n], 0, 0, 0); }
    }
}
__device__ __forceinline__ void sk_rstd64(const float* sss, int fr, int fq, float& r0, float& r1) {
    float a = 0.f, b = 0.f;
#pragma unroll
    for (int k = 0; k < 16; ++k) { a += sss[(16 * fq + k) * 32 + fr]; b += sss[(16 * fq + k) * 32 + fr + 16]; }
    a += __shfl_xor(a, 16); a += __shfl_xor(a, 32); b += __shfl_xor(b, 16); b += __shfl_xor(b, 32);
    r0 = 1.0f / sqrtf(a * (1.0f / DM) + RMS_EPS); r1 = 1.0f / sqrtf(b * (1.0f / DM) + RMS_EPS);
}
__device__ __forceinline__ void sk_up(const Frame& F, const bf16_t* XB, const bf16_t* Wup, bf16_t* H, const float* ss0, const float* sss) {
    const int gw = F.vcu * NWAVES + F.wave, NGW = F.G * NWAVES, lane = F.lane, fr = lane & 15, fq = lane >> 4;
    for (int it = gw; it < FF / 16; it += NGW) {
        float rs[2];
        if (sss) sk_rstd64(sss, fr, fq, rs[0], rs[1]); else { rs[0] = rstd_of(ss0, MP + fr); rs[1] = rstd_of(ss0, MP + 16 + fr); }
        f32x4 acc[2][2] = {};
        const bf16_t* const Bp[2] = {Wup + (size_t)(16 * it) * DM, Wup + (size_t)(FF + 16 * it) * DM};
        sk_mma<2>(XB + (size_t)MP * DM, DM, Bp, DM, 0, DM, acc, lane);
#pragma unroll
        for (int m = 0; m < 2; ++m) { const f32x4 gt = acc[m][0] * rs[m], up = acc[m][1] * rs[m]; f32x4 h;
#pragma unroll
            for (int e = 0; e < 4; ++e) h[e] = gt[e] * sigmoidf_(gt[e]) * up[e];
            *(u32x2*)(H + (size_t)(MP + 16 * m + fr) * FF + 16 * it + 4 * fq) = pack4(h); }
    }
}
template <int KS> __device__ __forceinline__ void sk_res(const Frame& F, const bf16_t* A, int K, const bf16_t* Wt, float* XS, bf16_t* XBs, float* sss_out, float scale) {
    const int nwg = (64 * KS + NWAVES - 1) / NWAVES;
    if (F.vcu >= nwg) return;
    const int gw = F.vcu * NWAVES + F.wave, lane = F.lane, fr = lane & 15, fq = lane >> 4, it = gw / KS, sl = gw % KS;
    f32x4 acc[2][1] = {};
    if (it < 64) { const bf16_t* const Bp[1] = {Wt + (size_t)(16 * it) * K}; const int kc = K / KS; sk_mma<1>(A, K, Bp, K, sl * kc, (sl + 1) * kc, acc, lane); }
    LAS f32x4* red = (LAS f32x4*)(F.lds + 98304) + F.wave * 128;
    if (KS > 1) { red[lane] = acc[0][0]; red[64 + lane] = acc[1][0]; __syncthreads(); }
    if (it < 64 && sl == 0) {
#pragma unroll
        for (int k = 1; k < KS; ++k) { acc[0][0] += red[k * 128 + lane]; acc[1][0] += red[k * 128 + 64 + lane]; }
#pragma unroll
        for (int m = 0; m < 2; ++m) { const int row = 16 * m + fr; const size_t o = (size_t)row * DM + 16 * it + 4 * fq;
            const f32x4 v = *(const f32x4*)(XS + o) + acc[m][0] * scale; *(f32x4*)(XS + o) = v;
            if (XBs) *(u32x2*)(XBs + o) = pack4(v);
            float q = (v[0] * v[0] + v[1] * v[1]) + (v[2] * v[2] + v[3] * v[3]); q += __shfl_xor(q, 16); q += __shfl_xor(q, 32);
            if (fq == 0) sss_out[it * 32 + row] = q; }
    }
    if (KS > 1) __syncthreads();
}
__device__ __forceinline__ void sk_in(const Frame& F, const bf16_t* XB, const bf16_t* Win, const float* sss, bf16_t* U, bf16_t* QKV, bf16_t* G, float* out) {
    const int gw = F.vcu * NWAVES + F.wave, NGW = F.G * NWAVES, lane = F.lane, fr = lane & 15, fq = lane >> 4;
    for (int it = gw; it < INW / 32; it += NGW) {
        const int blk = it >> 1, c0 = 64 * blk + 16 * (it & 1);
        float rs[2]; sk_rstd64(sss, fr, fq, rs[0], rs[1]);
        f32x4 acc[2][2] = {};
        const bf16_t* const Bp[2] = {Win + (size_t)c0 * DM, Win + (size_t)(c0 + 32) * DM};
        sk_mma<2>(XB + (size_t)MP * DM, DM, Bp, DM, 0, DM, acc, lane);
        const int cl = 16 * (it & 1) + 4 * fq;
#pragma unroll
        for (int m = 0; m < 2; ++m) {
            const int n = 16 * m + fr; const size_t r = (size_t)MP + n; const f32x4 z0 = acc[m][0] * rs[m], z1 = acc[m][1] * rs[m];
            if (blk < 8) {
                const int c = 64 * blk + cl; float* po = out + O_POOLS + (size_t)(n * 15 + 14) * PW;
                *(u32x2*)(U + r * PW + c) = pack4(z0); *(u32x2*)(U + r * PW + c + 32) = pack4(z1); *(f32x4*)(po + c) = z0; *(f32x4*)(po + c + 32) = z1;
            } else if (blk < 44) {
                const int j = blk - 8, g = j / 12, rem = j - 12 * g, which = rem >> 2, h = rem & 3, W = 128 << (2 * g);
                bf16_t* qrow = QKV + r * QKVW + g * 768 + which * 256 + h * 64 + cl;
                const size_t oks = (g == 0) ? O_KV128S : (g == 1) ? O_KV512S : O_KV2048S;
                float* kvo = out + oks + ((size_t)(n * W + (W - 1)) * 2 + (which - 1)) * 256 + h * 64 + cl;
                if (which == 2) { *(u32x2*)qrow = pack4(z0); *(u32x2*)(qrow + 32) = pack4(z1); *(f32x4*)kvo = z0; *(f32x4*)(kvo + 32) = z1; }
                else {
                    f32x4 cs, sn;
#pragma unroll
                    for (int e = 0; e < 4; ++e) { float s_, c_; sincos_rev((float)PAST * __builtin_amdgcn_exp2f(-(float)(cl + e) * (13.287712379549449f / 32.0f)), s_, c_); cs[e] = c_; sn[e] = s_; }
                    const float sc = (which == 0) ? C2 : 1.0f; const f32x4 t1 = z0 * sc, t2 = z1 * sc, o1 = t1 * cs - t2 * sn, o2 = t1 * sn + t2 * cs;
                    *(u32x2*)qrow = pack4(o1); *(u32x2*)(qrow + 32) = pack4(o2);
                    if (which == 1) { *(f32x4*)kvo = o1; *(f32x4*)(kvo + 32) = o2; }
                }
            } else {
                const int c = 64 * (blk - 44) + cl; f32x4 s0, s1;
#pragma unroll
                for (int e = 0; e < 4; ++e) { s0[e] = sigmoidf_(z0[e]); s1[e] = sigmoidf_(z1[e]); }
                *(u32x2*)(G + r * GW + c) = pack4(s0); *(u32x2*)(G + r * GW + c + 32) = pack4(s1);
            }
        }
    }
}
__device__ __forceinline__ void sk_br(const Frame& F, const bf16_t* P, const bf16_t* ATT, const bf16_t* Wcomb, const bf16_t* Wab, const bf16_t* G, bf16_t* MG) {
    const int gw = F.vcu * NWAVES + F.wave, NGW = F.G * NWAVES, lane = F.lane, fr = lane & 15, fq = lane >> 4;
    for (int it = gw; it < 64; it += NGW) {
        f32x4 ap[2][1] = {}, aa[2][1] = {};
        { const bf16_t* const Bp[1] = {Wcomb + (size_t)(16 * it) * PW}; sk_mma<1>(P + (size_t)MP * PW, PW, Bp, PW, 0, PW, ap, lane); }
        { const bf16_t* const Bp[1] = {Wab + (size_t)(16 * it) * AW}; sk_mma<1>(ATT + (size_t)MP * AW, AW, Bp, AW, 0, AW, aa, lane); }
#pragma unroll
        for (int m = 0; m < 2; ++m) { const size_t r = (size_t)MP + 16 * m + fr; const int c = 16 * it + 4 * fq;
            const u32x2 gp = *(const u32x2*)(G + r * GW + c), ga = *(const u32x2*)(G + r * GW + DM + c);
            f32x4 v; v[0] = ap[m][0][0] * bflo(gp.x) + aa[m][0][0] * bflo(ga.x); v[1] = ap[m][0][1] * bfhi(gp.x) + aa[m][0][1] * bfhi(ga.x);
            v[2] = ap[m][0][2] * bflo(gp.y) + aa[m][0][2] * bflo(ga.y); v[3] = ap[m][0][3] * bfhi(gp.y) + aa[m][0][3] * bfhi(ga.y);
            *(u32x2*)(MG + r * DM + c) = pack4(v); }
    }
}

__device__ __forceinline__ void p0_transpose_item(const float* W, const float* gain, int K, int N, bf16_t* WT, int row_off, LAS float* scr, int item, int lane) {
    const int nblk = N / 32, kb = item / nblk, nb = item % nblk, k0 = 64 * kb, n0 = 32 * nb;
#pragma unroll 8
    for (int i = 0; i < 32; ++i) { const int kk = 2 * i + (lane >> 5); float v = W[(size_t)(k0 + kk) * N + n0 + (lane & 31)]; if (gain) v *= gain[k0 + kk]; scr[kk * 33 + (lane & 31)] = v; }
    LDS_WAIT(); asm volatile("" ::: "memory");
    const int c = lane & 7;
#pragma unroll
    for (int j = 0; j < 4; ++j) { const int n = (lane >> 3) + 8 * j; const LAS float* s = scr + (8 * c) * 33 + n;
        u32x4 o; o.x = cvt_pk_bf16(s[0 * 33], s[1 * 33]); o.y = cvt_pk_bf16(s[2 * 33], s[3 * 33]); o.z = cvt_pk_bf16(s[4 * 33], s[5 * 33]); o.w = cvt_pk_bf16(s[6 * 33], s[7 * 33]);
        *(u32x4*)(WT + (size_t)(row_off + n0 + n) * K + k0 + 8 * c) = o; }
    LDS_WAIT(); asm volatile("" ::: "memory");
}
__device__ __forceinline__ float wave_sum(float v) {
#pragma unroll
    for (int o = 1; o < 64; o <<= 1) v += __shfl_xor(v, o);
    return v;
}

__device__ __forceinline__ void p0_prologue(const Frame& F, const Args& a) {
    unsigned char* ws = a.ws;
    LAS float* scr = (LAS float*)(F.lds + RING_OFF + F.wave * 16384);
    const int gw = F.vcu * NWAVES + F.wave, NGW = F.G * NWAVES;
    constexpr int I_UP = (DM / 64) * (FF / 32), I_DN = (FF / 64) * (DM / 32), I_IN = (DM / 64) * (INW / 32), I_AB = (AW / 64) * (DM / 32), I_O = (DM / 64) * (DM / 32), I_CMB = 1024;
    constexpr int NITEMS = 4 * I_UP + 2 * I_DN + I_IN + I_AB + I_O + I_CMB;
    for (int it = gw; it < NITEMS; it += NGW) {
        int r = it;
        if (r < I_UP) { p0_transpose_item(a.in[7], a.in[6], DM, FF, (bf16_t*)(ws + WS_W1UP), 0, scr, r, F.lane); continue; } r -= I_UP;
        if (r < I_UP) { p0_transpose_item(a.in[8], a.in[6], DM, FF, (bf16_t*)(ws + WS_W1UP), FF, scr, r, F.lane); continue; } r -= I_UP;
        if (r < I_DN) { p0_transpose_item(a.in[9], nullptr, FF, DM, (bf16_t*)(ws + WS_W1DN), 0, scr, r, F.lane); continue; } r -= I_DN;
        if (r < I_IN) { p0_transpose_item(a.in[11], a.in[10], DM, INW, (bf16_t*)(ws + WS_WIN), 0, scr, r, F.lane); continue; } r -= I_IN;
        if (r < I_AB) { p0_transpose_item(a.in[15], nullptr, AW, DM, (bf16_t*)(ws + WS_WAB), 0, scr, r, F.lane); continue; } r -= I_AB;
        if (r < I_O) { p0_transpose_item(a.in[16], nullptr, DM, DM, (bf16_t*)(ws + WS_WO), 0, scr, r, F.lane); continue; } r -= I_O;
        if (r < I_UP) { p0_transpose_item(a.in[18], a.in[17], DM, FF, (bf16_t*)(ws + WS_W2UP), 0, scr, r, F.lane); continue; } r -= I_UP;
        if (r < I_UP) { p0_transpose_item(a.in[19], a.in[17], DM, FF, (bf16_t*)(ws + WS_W2UP), FF, scr, r, F.lane); continue; } r -= I_UP;
        if (r < I_DN) { p0_transpose_item(a.in[20], nullptr, FF, DM, (bf16_t*)(ws + WS_W2DN), 0, scr, r, F.lane); continue; } r -= I_DN;
        {
            const int nb = r & 15, kc = r >> 4, k0 = kc * 8, g = k0 >> 7, c0 = k0 & 127, n = nb * 64 + F.lane;
            const float* wgrp = a.in[12] + (size_t)(g * 128 + c0) * 128; const float* scl = a.in[13] + g * 128; const float* wpb = a.in[14] + (size_t)(g * 128) * DM + n;
            float ac[8] = {0.f, 0.f, 0.f, 0.f, 0.f, 0.f, 0.f, 0.f};
            for (int d = 0; d < 128; ++d) { const float wv = wpb[(size_t)d * DM] * scl[d];
#pragma unroll
                for (int i = 0; i < 8; ++i) ac[i] += wgrp[i * 128 + d] * wv; }
            u32x4 o; o.x = cvt_pk_bf16(ac[0], ac[1]); o.y = cvt_pk_bf16(ac[2], ac[3]); o.z = cvt_pk_bf16(ac[4], ac[5]); o.w = cvt_pk_bf16(ac[6], ac[7]);
            *(u32x4*)((bf16_t*)(ws + WS_WCOMB) + (size_t)n * PW + k0) = o;
        }
    }
    float* ss0 = (float*)(ws + WS_CTL) + CW_SS;
    for (int m = gw; m < MP + NS; m += NGW) {
        const float* xr = (m < MP) ? a.in[0] + (size_t)m * DM : a.in[1] + (size_t)(m - MP) * DM;
        const f32x4* x4 = (const f32x4*)xr + F.lane; f32x4 v[4]; float s = 0.f;
#pragma unroll
        for (int j = 0; j < 4; ++j) { v[j] = x4[64 * j]; s += (v[j].x * v[j].x + v[j].y * v[j].y) + (v[j].z * v[j].z + v[j].w * v[j].w); }
        s = wave_sum(s);
        u32x2* o8 = (u32x2*)((bf16_t*)(ws + WS_XB) + (size_t)m * DM) + F.lane;
#pragma unroll
        for (int j = 0; j < 4; ++j) o8[64 * j] = pack4(v[j]);
        if (m >= MP) { f32x4* xs4 = (f32x4*)((float*)(ws + WS_XS) + (size_t)(m - MP) * DM) + F.lane;
#pragma unroll
            for (int j = 0; j < 4; ++j) xs4[64 * j] = v[j]; }
        if (F.lane == 0) ss0[m] = s;
    }
    const size_t gt = (size_t)F.vcu * (NWAVES * 64) + F.tid, NT = (size_t)F.G * NWAVES * 64;
#define COPY_SHIFT(src, dstoff, ROWS, RW4) do { const f32x4* s4 = (const f32x4*)(src); f32x4* d4 = (f32x4*)(a.out + (dstoff)); \
        const size_t per = (size_t)((ROWS) - 1) * (RW4), tot = (size_t)NS * per; \
        for (size_t i = gt; i < tot; i += NT) { const size_t n = i / per, rem = i - n * per; d4[n * (size_t)(ROWS) * (RW4) + rem] = s4[n * (size_t)(ROWS) * (RW4) + (RW4) + rem]; } } while (0)
    COPY_SHIFT(a.in[5], O_KV2048S, 2048, 128);
    COPY_SHIFT(a.in[4], O_KV512S, 512, 128);
    COPY_SHIFT(a.in[3], O_KV128S, 128, 128);
    COPY_SHIFT(a.in[2], O_POOLS, 15, 128);
#undef COPY_SHIFT
}

namespace att {
__device__ __forceinline__ int crow(int r, int hi) { return (r & 3) + 8 * (r >> 2) + 4 * hi; }
typedef short v4i16_t __attribute__((ext_vector_type(4)));
__device__ __forceinline__ s16x4 vtr(LAS const unsigned char* p) { return __builtin_bit_cast(s16x4, __builtin_amdgcn_ds_read_tr16_b64_v4i16((LAS v4i16_t*)p)); }
__device__ __forceinline__ float swapmax(float m) { auto rr = __builtin_amdgcn_permlane32_swap(__float_as_uint(m), __float_as_uint(m), false, false); return fmaxf(__uint_as_float(rr[0]), __uint_as_float(rr[1])); }
__device__ __forceinline__ float swapsum(float m) { auto rr = __builtin_amdgcn_permlane32_swap(__float_as_uint(m), __float_as_uint(m), false, false); return __uint_as_float(rr[0]) + __uint_as_float(rr[1]); }

__device__ __forceinline__ void task(const bf16_t* QKV, int colq, long kbase, int kstride, int qs0, int tlo, int thi, LAS unsigned char* vb,
                                     bf16_t* OGp  , float* LSEp  , int lane) {
    const int r32 = lane & 31, hi = lane >> 5;
    const long qrow = kbase + (long)(qs0 + r32) * kstride;
    bf16x8 qr[4];
#pragma unroll
    for (int d0 = 0; d0 < 4; ++d0) qr[d0] = *(const bf16x8*)(QKV + qrow * QKVW + colq + 16 * d0 + 8 * hi);
    const bf16_t* kcol = QKV + colq + 256 + 8 * hi;
    const bf16_t* vcol = QKV + colq + 512 + (lane & 7) * 8;
    const int vwoff = ((lane & 7) >> 2) * 2048 + ((lane & 7) & 3) * 16;
    const int vroff = ((lane >> 4) & 1) * 32 + (lane & 3) * 8 + (4 * hi + ((lane & 15) >> 2)) * 64;
    bf16x8 kf[4]; u32x4 vr[4];
    {
        const long kr = kbase + (long)(32 * tlo + r32) * kstride;
#pragma unroll
        for (int d0 = 0; d0 < 4; ++d0) kf[d0] = *(const bf16x8*)(kcol + kr * QKVW + 16 * d0);
#pragma unroll
        for (int i = 0; i < 4; ++i) { const long vrw = kbase + (long)(32 * tlo + i * 8 + (lane >> 3)) * kstride; vr[i] = *(const u32x4*)(vcol + vrw * QKVW); }
    }
    f32x16 o0 = {}, o1 = {}; float m_run = -1e30f, l_run = 0.f;
    for (int T = tlo; T <= thi; ++T) {
        LAS unsigned char* vbuf = vb + ((T & 1) ? 4096 : 0);
#pragma unroll
        for (int i = 0; i < 4; ++i) { const int row = i * 8 + (lane >> 3); *(LAS u32x4*)(vbuf + vwoff + (row >> 4) * 1024 + (row & 15) * 64) = vr[i]; }
        bf16x8 kn[4]; u32x4 vn[4];
        const int Tn = (T < thi) ? T + 1 : T;
        {
            const long kr = kbase + (long)(32 * Tn + r32) * kstride;
#pragma unroll
            for (int d0 = 0; d0 < 4; ++d0) kn[d0] = *(const bf16x8*)(kcol + kr * QKVW + 16 * d0);
#pragma unroll
            for (int i = 0; i < 4; ++i) { const long vrw = kbase + (long)(32 * Tn + i * 8 + (lane >> 3)) * kstride; vn[i] = *(const u32x4*)(vcol + vrw * QKVW); }
        }
        f32x16 p = {};
#pragma unroll
        for (int d0 = 0; d0 < 4; ++d0) p = __builtin_amdgcn_mfma_f32_32x32x16_bf16(kf[d0], qr[d0], p, 0, 0, 0);
        if (T == tlo || T == thi) {
            const int qs = qs0 + r32;
#pragma unroll
            for (int r = 0; r < 16; ++r) { const int ks = 32 * T + crow(r, hi); if (ks > qs || ks < qs - 128) p[r] = -1e30f; }
        }
        float rm = p[0];
#pragma unroll
        for (int r = 1; r < 16; ++r) rm = fmaxf(rm, p[r]);
        rm = swapmax(rm);
        const float mn = fmaxf(m_run, rm), alpha = __builtin_amdgcn_exp2f(m_run - mn); m_run = mn;
        float ls = 0.f;
#pragma unroll
        for (int r = 0; r < 16; ++r) { p[r] = __builtin_amdgcn_exp2f(p[r] - mn); ls += p[r]; }
        l_run = l_run * alpha + ls;
#pragma unroll
        for (int r = 0; r < 16; ++r) { o0[r] *= alpha; o1[r] *= alpha; }
        u32x4 pw0, pw1;
        pw0.x = cvt_pk_bf16(p[0], p[1]); pw0.y = cvt_pk_bf16(p[2], p[3]); pw0.z = cvt_pk_bf16(p[4], p[5]); pw0.w = cvt_pk_bf16(p[6], p[7]);
        pw1.x = cvt_pk_bf16(p[8], p[9]); pw1.y = cvt_pk_bf16(p[10], p[11]); pw1.z = cvt_pk_bf16(p[12], p[13]); pw1.w = cvt_pk_bf16(p[14], p[15]);
        const LAS unsigned char* vp = vbuf + vroff;
#define VFRAG(d0, s) ({ const s16x4 lo_ = vtr(vp + (d0) * 2048 + (s) * 1024), hi_ = vtr(vp + (d0) * 2048 + (s) * 1024 + 512); \
            (bf16x8){lo_[0], lo_[1], lo_[2], lo_[3], hi_[0], hi_[1], hi_[2], hi_[3]}; })
        o0 = __builtin_amdgcn_mfma_f32_32x32x16_bf16(VFRAG(0, 0), __builtin_bit_cast(bf16x8, pw0), o0, 0, 0, 0);
        o0 = __builtin_amdgcn_mfma_f32_32x32x16_bf16(VFRAG(0, 1), __builtin_bit_cast(bf16x8, pw1), o0, 0, 0, 0);
        o1 = __builtin_amdgcn_mfma_f32_32x32x16_bf16(VFRAG(1, 0), __builtin_bit_cast(bf16x8, pw0), o1, 0, 0, 0);
        o1 = __builtin_amdgcn_mfma_f32_32x32x16_bf16(VFRAG(1, 1), __builtin_bit_cast(bf16x8, pw1), o1, 0, 0, 0);
#undef VFRAG
#pragma unroll
        for (int d0 = 0; d0 < 4; ++d0) kf[d0] = kn[d0];
#pragma unroll
        for (int i = 0; i < 4; ++i) vr[i] = vn[i];
    }
    const float lt = swapsum(l_run), il = 1.0f / lt;
    bf16_t* op = OGp + qrow * 768;
#pragma unroll
    for (int a4 = 0; a4 < 4; ++a4) {
        u32x2 w0, w1;
        w0.x = cvt_pk_bf16(o0[4 * a4] * il, o0[4 * a4 + 1] * il); w0.y = cvt_pk_bf16(o0[4 * a4 + 2] * il, o0[4 * a4 + 3] * il);
        w1.x = cvt_pk_bf16(o1[4 * a4] * il, o1[4 * a4 + 1] * il); w1.y = cvt_pk_bf16(o1[4 * a4 + 2] * il, o1[4 * a4 + 3] * il);
        *(u32x2*)(op + 8 * a4 + 4 * hi) = w0; *(u32x2*)(op + 32 + 8 * a4 + 4 * hi) = w1;
    }
    if (hi == 0) LSEp[qrow * 12] = m_run + __builtin_amdgcn_logf(lt);
}

__device__ __forceinline__ void sample_task(const bf16_t* QKV, const float* cache, int W, int dil, int n, int h, int g, LAS float* sc, bf16_t* OG, float* LSE, int lane) {
    const long row = MP + n; const bf16_t* qp = QKV + row * QKVW + g * 768 + h * 64;
    const int dch = lane & 15, jl = lane >> 4;
    f32x4 q4; { const u32x2 w = *(const u32x2*)(qp + 4 * dch); q4 = (f32x4){bflo(w.x), bfhi(w.x), bflo(w.y), bfhi(w.y)}; }
    for (int it = 0; it < 33; ++it) {
        const int j = 4 * it + jl; f32x4 k4 = {0.f, 0.f, 0.f, 0.f};
        if (j == 0) { const u32x2 w = *(const u32x2*)(qp + 256 + 4 * dch); k4 = (f32x4){bflo(w.x), bfhi(w.x), bflo(w.y), bfhi(w.y)}; }
        else if (j <= 128) k4 = *(const f32x4*)(cache + ((size_t)(n * W + (W - dil * j)) * 2 + 0) * 256 + h * 64 + 4 * dch);
        float s = (k4[0] * q4[0] + k4[1] * q4[1]) + (k4[2] * q4[2] + k4[3] * q4[3]);
        s += __shfl_xor(s, 1); s += __shfl_xor(s, 2); s += __shfl_xor(s, 4); s += __shfl_xor(s, 8);
        if (dch == 0) sc[j] = (j <= 128) ? s : -1e30f;
    }
    LDS_WAIT(); asm volatile("" ::: "memory");
    float s0 = sc[lane], s1 = sc[lane + 64], s2 = (lane < 4) ? sc[lane + 128] : -1e30f;
    float mx = fmaxf(fmaxf(s0, s1), s2);
#pragma unroll
    for (int o = 1; o < 64; o <<= 1) mx = fmaxf(mx, __shfl_xor(mx, o));
    const float p0 = __builtin_amdgcn_exp2f(s0 - mx), p1 = __builtin_amdgcn_exp2f(s1 - mx), p2 = __builtin_amdgcn_exp2f(s2 - mx);
    const float l = wave_sum(p0 + p1 + p2);
    LDS_WAIT(); asm volatile("" ::: "memory");
    sc[lane] = p0; sc[lane + 64] = p1; if (lane < 4) sc[lane + 128] = p2;
    LDS_WAIT(); asm volatile("" ::: "memory");
    f32x4 ac = {0.f, 0.f, 0.f, 0.f};
    for (int it = 0; it < 33; ++it) {
        const int j = 4 * it + jl; f32x4 v4 = {0.f, 0.f, 0.f, 0.f}; const float pj = sc[j];
        if (j == 0) { const u32x2 w = *(const u32x2*)(qp + 512 + 4 * dch); v4 = (f32x4){bflo(w.x), bfhi(w.x), bflo(w.y), bfhi(w.y)}; }
        else if (j <= 128) v4 = *(const f32x4*)(cache + ((size_t)(n * W + (W - dil * j)) * 2 + 1) * 256 + h * 64 + 4 * dch);
        ac += v4 * pj;
    }
#pragma unroll
    for (int e = 0; e < 4; ++e) { ac[e] += __shfl_xor(ac[e], 16); ac[e] += __shfl_xor(ac[e], 32); }
    const float il = 1.0f / l;
    if (lane < 16) *(u32x2*)(OG + row * 768 + g * 256 + h * 64 + 4 * dch) = pack4(ac * il);
    if (lane == 0) LSE[row * 12 + g * 4 + h] = mx + __builtin_amdgcn_logf(l);
    LDS_WAIT(); asm volatile("" ::: "memory");
}

__device__ __forceinline__ void merge_row(const bf16_t* OG, const float* LSE, bf16_t* ATT, long row, int h, int ch) {
    const float l0 = LSE[row * 12 + h], l1 = LSE[row * 12 + 4 + h], l2 = LSE[row * 12 + 8 + h];
    const float mx = fmaxf(fmaxf(l0, l1), l2);
    float w0 = __builtin_amdgcn_exp2f(l0 - mx), w1 = __builtin_amdgcn_exp2f(l1 - mx), w2 = __builtin_amdgcn_exp2f(l2 - mx);
    const float inv = 1.0f / (w0 + w1 + w2); w0 *= inv; w1 *= inv; w2 *= inv;
    const bf16_t* p = OG + row * 768 + h * 64 + 8 * ch;
    const u32x4 a = *(const u32x4*)p, b = *(const u32x4*)(p + 256), c = *(const u32x4*)(p + 512);
    u32x4 o;
    o.x = cvt_pk_bf16(w0 * bflo(a.x) + w1 * bflo(b.x) + w2 * bflo(c.x), w0 * bfhi(a.x) + w1 * bfhi(b.x) + w2 * bfhi(c.x));
    o.y = cvt_pk_bf16(w0 * bflo(a.y) + w1 * bflo(b.y) + w2 * bflo(c.y), w0 * bfhi(a.y) + w1 * bfhi(b.y) + w2 * bfhi(c.y));
    o.z = cvt_pk_bf16(w0 * bflo(a.z) + w1 * bflo(b.z) + w2 * bflo(c.z), w0 * bfhi(a.z) + w1 * bfhi(b.z) + w2 * bfhi(c.z));
    o.w = cvt_pk_bf16(w0 * bflo(a.w) + w1 * bflo(b.w) + w2 * bflo(c.w), w0 * bfhi(a.w) + w1 * bfhi(b.w) + w2 * bfhi(c.w));
    *(u32x4*)(ATT + row * AW + h * 64 + 8 * ch) = o;
}
}

__device__ __forceinline__ void p4_mixers(const Frame& F, const Args& a) {
    unsigned char* ws = a.ws;
    const bf16_t* QKV = (const bf16_t*)(ws + WS_QKV); const bf16_t* U = (const bf16_t*)(ws + WS_U);
    bf16_t* OG = (bf16_t*)(a.out + O_YP); float* LSE = (float*)((unsigned char*)OG + OG_BYTES); bf16_t* ATT = (bf16_t*)(ws + WS_ATT); bf16_t* P = (bf16_t*)(ws + WS_P);
    const int lane = F.lane, wv = F.wave;
    for (int unit = F.vcu; unit < 256; unit += F.G) {
        const int b = unit >> 4, h = (unit >> 2) & 3, blk = unit & 3;
        if (unit < 128 && wv < 3) {
            const int n = unit >> 2, hh = unit & 3;
            const float* cache = (wv == 0) ? a.in[3] : (wv == 1) ? a.in[4] : a.in[5];
            att::sample_task(QKV, cache, 128 << (2 * wv), 1 << (2 * wv), n, hh, wv, (LAS float*)(F.lds + 65536 + wv * 1024), OG, LSE, lane);
        }
        LAS unsigned char* vb = F.lds + wv * 8192;
        const long tok0 = (long)b * SEQ;
#pragma unroll 1
        for (int g = 0; g < 3; ++g) {
            const int dil = 1 << (2 * g), ns = 512 / dil;
#pragma unroll 1
            for (int sub = 0; sub < 2; ++sub) {
                const int f = (2 * wv + sub) * 32;
                const int rho = f / ns, sl = f - rho * ns;
                const int qs0 = blk * ns + sl;
                const int tlo = (qs0 >= 128) ? (qs0 - 128) / 32 : 0, thi = qs0 / 32;
                att::task(QKV, g * 768 + h * 64, tok0 + rho, dil, qs0, tlo, thi, vb, OG + g * 256 + h * 64, LSE + g * 4 + h, lane);
            }
        }
        {
            const int gi = h, w = 2 << gi, ch = F.tid & 15, rg = F.tid >> 4, t0 = blk * 512 + rg * 16;
            const bf16_t* up = U + (size_t)tok0 * PW + gi * 128 + ch * 8; bf16_t* pp = P + (size_t)tok0 * PW + gi * 128 + ch * 8;
            float S[8] = {0.f, 0.f, 0.f, 0.f, 0.f, 0.f, 0.f, 0.f};
            for (int i = 1; i < w; ++i) { const int t = t0 - i; if (t >= 0) { const u32x4 x = *(const u32x4*)(up + (size_t)t * PW);
                S[0] += bflo(x.x); S[1] += bfhi(x.x); S[2] += bflo(x.y); S[3] += bfhi(x.y); S[4] += bflo(x.z); S[5] += bfhi(x.z); S[6] += bflo(x.w); S[7] += bfhi(x.w); } }
#pragma unroll 4
            for (int i = 0; i < 16; ++i) { const int t = t0 + i; const u32x4 x = *(const u32x4*)(up + (size_t)t * PW);
                const float xv[8] = {bflo(x.x), bfhi(x.x), bflo(x.y), bfhi(x.y), bflo(x.z), bfhi(x.z), bflo(x.w), bfhi(x.w)};
                const float ic = 1.0f / (float)((t + 1 < w) ? t + 1 : w); float pv[8];
#pragma unroll
                for (int e = 0; e < 8; ++e) { S[e] += xv[e]; pv[e] = S[e] * ic - xv[e]; }
                u32x4 o; o.x = cvt_pk_bf16(pv[0], pv[1]); o.y = cvt_pk_bf16(pv[2], pv[3]); o.z = cvt_pk_bf16(pv[4], pv[5]); o.w = cvt_pk_bf16(pv[6], pv[7]);
                *(u32x4*)(pp + (size_t)t * PW) = o;
                const int tb = t - w + 1; if (tb >= 0) { const u32x4 y = *(const u32x4*)(up + (size_t)tb * PW);
                    S[0] -= bflo(y.x); S[1] -= bfhi(y.x); S[2] -= bflo(y.y); S[3] -= bfhi(y.y); S[4] -= bflo(y.z); S[5] -= bfhi(y.z); S[6] -= bflo(y.w); S[7] -= bfhi(y.w); } }
        }
#pragma unroll 1
        for (int g = 0; g < 3; ++g) {
            const int W = 128 << (2 * g), tlo = SEQ - W; if (blk * 512 + 512 <= tlo) continue;
            float* ob = a.out + ((g == 0) ? O_KV128P : (g == 1) ? O_KV512P : O_KV2048P);
            for (int idx = F.tid; idx < 512 * 16; idx += 512) { const int which = idx >> 12, rl = (idx >> 3) & 511, ch = idx & 7, t = blk * 512 + rl;
                if (t >= tlo) { const u32x4 w = *(const u32x4*)(QKV + (size_t)(tok0 + t) * QKVW + g * 768 + (1 + which) * 256 + h * 64 + ch * 8);
                    float* d = ob + ((size_t)(b * W + (t - tlo)) * 2 + which) * 256 + h * 64 + ch * 8;
                    *(f32x4*)d = (f32x4){bflo(w.x), bfhi(w.x), bflo(w.y), bfhi(w.y)}; *(f32x4*)(d + 4) = (f32x4){bflo(w.z), bfhi(w.z), bflo(w.w), bfhi(w.w)}; } }
        }
        if (unit >= 128 && unit < 160) {
            const int n = unit - 128, c = F.tid, gi = c >> 7, w = 2 << gi;
            const float un = bf2f(U[(size_t)(MP + n) * PW + c]); float S = un; const float* sp = a.in[2] + (size_t)n * 15 * PW + c;
            for (int i = 1; i < w; ++i) S += sp[(size_t)(15 - i) * PW];
            const float pv = S / (float)w - un;
            P[(size_t)(MP + n) * PW + c] = (bf16_t)(cvt_pk_bf16(pv, 0.f) & 0xffffu);
        }
        asm volatile("s_waitcnt vmcnt(0)" ::: "memory");
        __syncthreads();
        { const int rl = F.tid >> 3, ch = F.tid & 7;
#pragma unroll 2
            for (int it = 0; it < 8; ++it) att::merge_row(OG, LSE, ATT, tok0 + blk * 512 + it * 64 + rl, h, ch);
            if (unit < 128 && F.tid < 8) att::merge_row(OG, LSE, ATT, MP + (unit >> 2), unit & 3, F.tid);
        }
        __syncthreads();
    }
}

__device__ __forceinline__ void p9_final(const Frame& F, const Args& a) {
    const float* ss3 = (const float*)(a.ws + WS_SSP) + 2 * SSP_STRIDE; const f32x4* g4 = (const f32x4*)a.in[21] + F.lane;
    const int gw = F.vcu * NWAVES + F.wave, NGW = F.G * NWAVES;
    f32x4 gv[4];
#pragma unroll
    for (int j = 0; j < 4; ++j) gv[j] = g4[64 * j];
    for (int m = gw; m < MP + NS; m += NGW) {
        const float* src = (m < MP) ? a.out + O_YP + (size_t)m * DM : (const float*)(a.ws + WS_XS) + (size_t)(m - MP) * DM;
        float* dst = (m < MP) ? a.out + O_YP + (size_t)m * DM : a.out + O_YS + (size_t)(m - MP) * DM;
        const float qp = (m < MP) ? (F.lane < 16 ? ss3[(size_t)F.lane * MT + m] : 0.f) : ((const float*)(a.ws + WS_SSS))[(2 * 64 + F.lane) * 32 + (m - MP)];
        const float rs = 1.0f / sqrtf(wave_sum(qp) * (1.0f / DM) + RMS_EPS);
        const f32x4* s4 = (const f32x4*)src + F.lane; f32x4* d4 = (f32x4*)dst + F.lane;
        f32x4 v[4];
#pragma unroll
        for (int j = 0; j < 4; ++j) v[j] = s4[64 * j];
#pragma unroll
        for (int j = 0; j < 4; ++j) d4[64 * j] = v[j] * rs * gv[j];
    }
}

constexpr int N_PHASES = 10;
__global__ void __launch_bounds__(NWAVES * 64, 2) hybrid_fwd(Args args) {
    extern __shared__ __attribute__((aligned(16))) unsigned char lds[];
    Frame F;
    F.lds = (LAS unsigned char*)lds;
    F.tid = threadIdx.x; F.lane = F.tid & 63; F.wave = __builtin_amdgcn_readfirstlane(F.tid >> 6);
    F.G = gridDim.x; { const int bx = blockIdx.x; F.vcu = (F.G % 8 == 0) ? (bx % 8) * (F.G / 8) + bx / 8 : bx; }
    unsigned char* ws = args.ws;
    gu32* ctl = (gu32*)(ws + WS_CTL);
    for (int u = F.tid; u < (LDS_BYTES - LDSCTL_OFF) / 4; u += NWAVES * 64) ((LAS unsigned*)(F.lds + LDSCTL_OFF))[u] = 0u;
    __syncthreads();
    XcdBarrier bar; bar.bar = (unsigned*)(ctl + CW_BAR); bar.x = 0; bar.st = nullptr;
    const int lo = args.ph_lo, hi = args.ph_hi;
    if (hi - lo > 1) bar = xcd_barrier_post((unsigned*)(ctl + CW_BAR), (volatile LAS unsigned*)(F.lds + MISC_OFF) + 8);
#define IN(k) (lo <= (k) && (k) < hi)
#define SEAM(k) do { if (IN(k) && IN((k) + 1)) xcd_barrier(bar); } while (0)
    float* ss0 = (float*)(ws + WS_CTL) + CW_SS; float* ssp = (float*)(ws + WS_SSP);
    bf16_t* XB = (bf16_t*)(ws + WS_XB); bf16_t* H = (bf16_t*)(ws + WS_H); float* XS = (float*)(ws + WS_XS);
    float* sss = (float*)(ws + WS_SSS);
    float* XRES = args.out + O_YP;

    if (IN(0)) { TWICE(0, p0_prologue(F, args)); } SEAM(0);
#ifdef DIAG_DUMP_W
    if (IN(0) && !IN(1)) { xcd_barrier(bar);
        const size_t gt = (size_t)F.vcu * 512 + F.tid, NT = (size_t)F.G * 512; const bf16_t* Wd = (const bf16_t*)(ws + WS_W1UP); float* y = args.out + O_YP;
        for (size_t i = gt; i < (WS_XS - WS_W1UP) / 2; i += NT) y[i] = bf2f(Wd[i]); }
#endif

    if (IN(1)) {
        sk_up(F, XB, (const bf16_t*)(ws + WS_W1UP), H, ss0, nullptr);
        pg8::Gemm g{XB, (const bf16_t*)(ws + WS_W1UP), MP, 2 * FF, DM, (size_t)128 * DM, (size_t)FF * DM}; pg8::StaticOrder S; S.init(MP, 2 * FF, F.G, (int)blockIdx.x);
        EpiUp<1> E{H, ss0};
        TWICE(1, pg8::gemm_phase<EpiUp<1>, pg8::StaticOrder, true, true>(F.lds + RING_OFF, g, S, E));
    } SEAM(1);
    if (IN(2)) {
        sk_res<4>(F, H + (size_t)MP * FF, FF, (const bf16_t*)(ws + WS_W1DN), XS, XB + (size_t)MP * DM, sss, 0.5f);
        pg8::Gemm g{H, (const bf16_t*)(ws + WS_W1DN), MP, DM, FF, (size_t)256 * FF, (size_t)128 * FF}; pg8::StaticOrder S; S.init(MP, DM, F.G, (int)blockIdx.x);
        EpiRes<true, false> E{args.in[0], nullptr, nullptr, XB, ssp, 0.5f};
        TWICE(2, pg8::gemm_phase<EpiRes<true, false>, pg8::StaticOrder, true, true>(F.lds + RING_OFF, g, S, E));
    } SEAM(2);
    if (IN(3)) {
        sk_in(F, XB, (const bf16_t*)(ws + WS_WIN), sss, (bf16_t*)(ws + WS_U), (bf16_t*)(ws + WS_QKV), (bf16_t*)(ws + WS_G), args.out);
        pg8::Gemm g{XB, (const bf16_t*)(ws + WS_WIN), MP, INW, DM, (size_t)256 * DM, (size_t)128 * DM}; pg8::StaticOrder S; S.init(MP, INW, F.G, (int)blockIdx.x);
        EpiIn E{ssp, (bf16_t*)(ws + WS_U), (bf16_t*)(ws + WS_QKV), (bf16_t*)(ws + WS_G), args.out};
        TWICE(3, pg8::gemm_phase<EpiIn, pg8::StaticOrder, true, true>(F.lds + RING_OFF, g, S, E));
    } SEAM(3);
    if (IN(4)) { TWICE(4, p4_mixers(F, args)); } SEAM(4);
#ifdef DIAG_DUMP_P4
    if (IN(4) && !IN(5)) { xcd_barrier(bar);
        const size_t gt = (size_t)F.vcu * 512 + F.tid, NT = (size_t)F.G * 512; const bf16_t* ATTd = (const bf16_t*)(ws + WS_ATT); const bf16_t* Pd = (const bf16_t*)(ws + WS_P); float* y = args.out + O_YP;
        for (size_t i = gt; i < (size_t)(MP + NS) * AW; i += NT) y[i] = bf2f(ATTd[i]);
        for (size_t i = gt; i < (size_t)(MP + NS) * PW; i += NT) y[(size_t)(MP + NS) * AW + i] = bf2f(Pd[i]); }
#endif
    if (IN(5)) {
        sk_br(F, (const bf16_t*)(ws + WS_P), (const bf16_t*)(ws + WS_ATT), (const bf16_t*)(ws + WS_WCOMB), (const bf16_t*)(ws + WS_WAB), (const bf16_t*)(ws + WS_G), (bf16_t*)(ws + WS_MG));
        { pg8::Gemm g{(const bf16_t*)(ws + WS_P), (const bf16_t*)(ws + WS_WCOMB), MP, DM, PW, (size_t)256 * PW, (size_t)128 * PW}; pg8::StaticOrder S; S.init(MP, DM, F.G, (int)blockIdx.x);
          EpiBr<0> E{(const bf16_t*)(ws + WS_G), (bf16_t*)(ws + WS_T1), (bf16_t*)(ws + WS_MG)};
          pg8::gemm_phase<EpiBr<0>, pg8::StaticOrder, true, true>(F.lds + RING_OFF, g, S, E); }
        asm volatile("s_waitcnt vmcnt(0)" ::: "memory"); __syncthreads();
        { pg8::Gemm g{(const bf16_t*)(ws + WS_ATT), (const bf16_t*)(ws + WS_WAB), MP, DM, AW, (size_t)256 * AW, (size_t)128 * AW}; pg8::StaticOrder S; S.init(MP, DM, F.G, (int)blockIdx.x);
          EpiBr<1> E{(const bf16_t*)(ws + WS_G), (bf16_t*)(ws + WS_T1), (bf16_t*)(ws + WS_MG)};
          pg8::gemm_phase<EpiBr<1>, pg8::StaticOrder, true, true>(F.lds + RING_OFF, g, S, E); }
    } SEAM(5);
#ifdef DIAG_DUMP
    if (IN(DIAG_STOP - 1) && !IN(DIAG_STOP)) { xcd_barrier(bar);
        const size_t gt = (size_t)F.vcu * 512 + F.tid, NT = (size_t)F.G * 512; const bf16_t* MGd = (const bf16_t*)(ws + DIAG_DUMP_OFF); float* y = args.out + O_YP;
        for (size_t i = gt; i < (size_t)MP * DM; i += NT) y[i] = bf2f(MGd[i]); }
#endif
    if (IN(6)) {
        sk_res<2>(F, (const bf16_t*)(ws + WS_MG) + (size_t)MP * DM, DM, (const bf16_t*)(ws + WS_WO), XS, XB + (size_t)MP * DM, sss + 64 * 32, 1.0f);
        pg8::Gemm g{(const bf16_t*)(ws + WS_MG), (const bf16_t*)(ws + WS_WO), MP, DM, DM, (size_t)256 * DM, (size_t)128 * DM}; pg8::StaticOrder S; S.init(MP, DM, F.G, (int)blockIdx.x);
        EpiRes<false, false> E{nullptr, XB, nullptr, XB, ssp + SSP_STRIDE, 1.0f};
        pg8::gemm_phase<EpiRes<false, false>, pg8::StaticOrder, true, true>(F.lds + RING_OFF, g, S, E);
    } SEAM(6);
    if (IN(7)) {
        sk_up(F, XB, (const bf16_t*)(ws + WS_W2UP), H, nullptr, sss + 64 * 32);
        pg8::Gemm g{XB, (const bf16_t*)(ws + WS_W2UP), MP, 2 * FF, DM, (size_t)128 * DM, (size_t)FF * DM}; pg8::StaticOrder S; S.init(MP, 2 * FF, F.G, (int)blockIdx.x);
        EpiUp<16> E{H, ssp + SSP_STRIDE};
        TWICE(7, pg8::gemm_phase<EpiUp<16>, pg8::StaticOrder, true, true>(F.lds + RING_OFF, g, S, E));
    } SEAM(7);
    if (IN(8)) {
        sk_res<4>(F, H + (size_t)MP * FF, FF, (const bf16_t*)(ws + WS_W2DN), XS, nullptr, sss + 2 * 64 * 32, 0.5f);
        pg8::Gemm g{H, (const bf16_t*)(ws + WS_W2DN), MP, DM, FF, (size_t)256 * FF, (size_t)128 * FF}; pg8::StaticOrder S; S.init(MP, DM, F.G, (int)blockIdx.x);
        EpiRes<false, true> E{nullptr, XB, XRES, nullptr, ssp + 2 * SSP_STRIDE, 0.5f};
        pg8::gemm_phase<EpiRes<false, true>, pg8::StaticOrder, true, true>(F.lds + RING_OFF, g, S, E);
    } SEAM(8);
    if (IN(9)) { p9_final(F, args); }
#undef IN
#undef SEAM
}

extern "C" void kernel_launch(void* const* d_in, const int* in_sizes, int n_in, void* d_out, int out_size, void* d_ws, size_t ws_size, hipStream_t stream) {
    static int grid = 0;
    if (grid == 0) {
        if (n_in != 22 || in_sizes[0] != MP * DM || (size_t)out_size != O_END || ws_size < WS_END) {
            fprintf(stderr, "kernel_launch: unexpected shapes (n_in %d, in0 %d, out %d, ws %zu need %zu); nothing launched\n", n_in, n_in > 0 ? in_sizes[0] : -1, out_size, ws_size, (size_t)WS_END); grid = -1; return; }
        int dev = 0, cus = 0, per_cu = 0;
        if (hipGetDevice(&dev) != hipSuccess || hipDeviceGetAttribute(&cus, hipDeviceAttributeMultiprocessorCount, dev) != hipSuccess) { grid = -1; return; }
        if (hipFuncSetAttribute((const void*)hybrid_fwd, hipFuncAttributeMaxDynamicSharedMemorySize, LDS_BYTES) != hipSuccess) { fprintf(stderr, "kernel_launch: hipFuncSetAttribute failed\n"); grid = -1; return; }
        if (hipOccupancyMaxActiveBlocksPerMultiprocessor(&per_cu, (const void*)hybrid_fwd, NWAVES * 64, LDS_BYTES) != hipSuccess || per_cu < 1) {
            fprintf(stderr, "kernel_launch: occupancy query reports %d workgroups per CU\n", per_cu); per_cu = 1; }
        (void)hipGetLastError();
        grid = cus;
    }
    if (grid < 0) return;
#ifdef DIAG_POISON
    (void)hipMemsetAsync((char*)d_ws, 0xAA, WS_END, stream); (void)hipMemsetAsync((char*)d_out, 0xAA, O_END * 4, stream);
#endif
    if (hipMemsetAsync((char*)d_ws + WS_CTL, 0, CTL_ZERO_BYTES, stream) != hipSuccess) { fprintf(stderr, "kernel_launch: memset failed\n"); return; }
    Args a{};
    for (int i = 0; i < 22; ++i) a.in[i] = (const float*)d_in[i];
    a.out = (float*)d_out; a.ws = (unsigned char*)d_ws;
    constexpr int NL = MK_N_LAUNCHES;
    for (int li = 0; li < NL; ++li) {
        a.ph_lo = (NL == 1) ? 0 : li; a.ph_hi = (NL == 1) ? N_PHASES : li + 1;
#ifdef DIAG_STOP
        a.ph_hi = DIAG_STOP;
#endif
        hipLaunchKernelGGL(hybrid_fwd, dim3(grid), dim3(NWAVES * 64), LDS_BYTES, stream, a);
        const hipError_t le = hipPeekAtLastError();
        if (le != hipSuccess) { fprintf(stderr, "kernel_launch: launch %d failed: %s\n", li, hipGetErrorName(le)); break; }
    }
}
```

```cpp
#include <hip/hip_runtime.h>
#include <cstdio>
#include <cstdint>

#ifndef DIAG_REPEAT
#define DIAG_REPEAT -1
#endif
#define TWICE(k, ...) do { __VA_ARGS__; if (DIAG_REPEAT == (k)) { xcd_barrier(bar); __VA_ARGS__; } } while (0)
#ifndef MK_N_LAUNCHES
#define MK_N_LAUNCHES 1
#endif

constexpr int DM = 1024, NB = 16, SEQ = 2048, NS = 32, PAST = 16384, FF = 2816, INW = 4864;
constexpr int MP = NB * SEQ;
constexpr int MT = MP + 256;
constexpr int QKVW = 2304, PW = 512, GW = 2048, AW = 256;
constexpr float RMS_EPS = 1e-6f;
constexpr float C2 = 0.125f * 1.4426950408889634f;

constexpr size_t O_YP = 0, O_YS = 33554432, O_POOLP = 33587200, O_KV128P = 33710080, O_KV512P = 34758656, O_KV2048P = 38952960,
                 O_POOLS = 55730176, O_KV128S = 55975936, O_KV512S = 58073088, O_KV2048S = 66461696, O_END = 100016128;

namespace pg8 {
#define PG8_LAS __attribute__((address_space(3)))
typedef unsigned short bf16_t;
typedef short bf16x8 __attribute__((ext_vector_type(8)));
typedef float f32x4 __attribute__((ext_vector_type(4)));
typedef float f32x2 __attribute__((ext_vector_type(2)));
typedef unsigned u32x4 __attribute__((ext_vector_type(4)));
typedef unsigned u32x2 __attribute__((ext_vector_type(2)));
constexpr int BM = 256, BK = 64, HALF = 128, HTB = HALF * BK * 2, STAGE_BYTES = 8 * HTB, NXCD = 8, WGM = 8;

__host__ __device__ __forceinline__ int lds_byte(int r, int c) { const int st = (r >> 4) * 2 + (c >> 5), rr = r & 15, cc = c & 31, ob = rr * 64 + cc * 2; return st * 1024 + (ob ^ (((ob >> 9) & 1) << 5)); }
__host__ __device__ __forceinline__ void stage_rc(int b, int& R, int& C) { const int st = b / 1024, sb = b % 1024, swz = sb ^ (((sb >> 9) & 1) << 5); R = (st >> 1) * 16 + swz / 64; C = (st & 1) * 32 + (swz % 64) / 2; }
__host__ __device__ __forceinline__ int perm32(int rho) { const int n = rho >> 4, i = rho & 15; return 8 * (i >> 2) + 4 * n + (i & 3); }

struct Unit { int pm, pn; };
struct Gemm { const bf16_t* A; const bf16_t* Bt; int M, N, K; size_t b_tile, b_half; };

struct StaticOrder {
    int nM, nN, nwg, G, c;
    __host__ __device__ void init(int M, int N, int G_, int c_) { nM = M / BM; nN = N / BM; nwg = nM * nN; G = G_; c = c_; }
    __host__ __device__ bool next(int i, Unit& u) const {
        const long L = (long)i * G + c; if (L >= nwg) return false;
        int wgid = (int)L; { const int q = nwg / NXCD, r = nwg % NXCD, xcd = wgid % NXCD, off = wgid / NXCD; wgid = (xcd < r ? xcd * (q + 1) : r * (q + 1) + (xcd - r) * q) + off; }
        const int nig = WGM * nN, gid = wgid / nig, fm = gid * WGM, gsz = (nM - fm) < WGM ? (nM - fm) : WGM;
        u.pm = fm + ((wgid % nig) % gsz); u.pn = (wgid % nig) / gsz; return true;
    }
};

typedef __bf16 bf16x2_t __attribute__((ext_vector_type(2)));
__device__ __forceinline__ unsigned cvt_pk_bf16(float lo, float hi) { const f32x2 v = {lo, hi}; const bf16x2_t b = __builtin_convertvector(v, bf16x2_t); return __builtin_bit_cast(unsigned, b); }

template <class Epi, class Sched, bool ALIGN_EPI = false, bool SP2 = false>
__device__ __forceinline__ void gemm_phase(PG8_LAS unsigned char* lds, const Gemm g, const Sched& S, const Epi& E) {
    const int tid = threadIdx.x, wid = __builtin_amdgcn_readfirstlane(tid >> 6), lane = tid & 63, wr = wid >> 2, wc = wid & 3, fr = lane & 15, fq = lane >> 4;
    const int K = g.K, nt = K / BK;
    unsigned voffA[2], voffB[2];
#pragma unroll
    for (int i = 0; i < 2; ++i) { int R, C; stage_rc(tid * 16 + i * 8192, R, C); int Rb = R;
        if constexpr (Epi::PERM == 1) Rb = (R & ~31) + perm32(R & 31);
        if constexpr (Epi::PERM == 2) Rb = (R & ~48) | (((R >> 4) & 1) << 5) | (((R >> 5) & 1) << 4);
        voffA[i] = (unsigned)(R * K + C) * 2u; voffB[i] = (unsigned)(Rb * K + C) * 2u; }
    const size_t kstep = (size_t)(BK * 2);
    const size_t hstep = (size_t)HALF * K * 2;
    const size_t tstep = 2 * hstep;
    const size_t bhstep = g.b_half * 2, btstep = g.b_tile * 2;
    const unsigned ldsw = (unsigned)wid * 1024u;
    const int aoff = lds_byte(wr * 64 + fr, fq * 8), boff = lds_byte(wc * 32 + fr, fq * 8);
#define PG8_SA(b, h) (((b) * 2 + (h)) * HTB)
#define PG8_SB(b, h) ((4 + (b) * 2 + (h)) * HTB)
#define PG8_STAGE(bufoff, gbase, voff) do { _Pragma("unroll") for (int _i = 0; _i < 2; ++_i) \
        __builtin_amdgcn_global_load_lds((const unsigned*)((const char*)(gbase) + (voff)[_i]), (PG8_LAS unsigned*)(lds + (bufoff) + ldsw + _i * 8192), 16, 0, 0); } while (0)
#define PG8_LDA(dst, b, h) do { _Pragma("unroll") for (int m = 0; m < 4; ++m) _Pragma("unroll") for (int k = 0; k < 2; ++k) dst[m][k] = *(const PG8_LAS bf16x8*)(lds + PG8_SA(b, h) + aoff + m * 2048 + k * 1024); } while (0)
#define PG8_LDB(dst, b, h) do { _Pragma("unroll") for (int n = 0; n < 2; ++n) _Pragma("unroll") for (int k = 0; k < 2; ++k) dst[n][k] = *(const PG8_LAS bf16x8*)(lds + PG8_SB(b, h) + boff + n * 2048 + k * 1024); } while (0)
#define PG8_MMA(ai, bj, At, Bt) do { __builtin_amdgcn_s_setprio(1); _Pragma("unroll") for (int m = 0; m < 4; ++m) _Pragma("unroll") for (int n = 0; n < 2; ++n) _Pragma("unroll") for (int k = 0; k < 2; ++k) \
        acc[ai][bj][m][n] = __builtin_amdgcn_mfma_f32_16x16x32_bf16(Bt[n][k], At[m][k], acc[ai][bj][m][n], 0, 0, 0); __builtin_amdgcn_s_setprio(0); } while (0)
#define PG8_WAIT_V(n) asm volatile("s_waitcnt vmcnt(" #n ")" ::: "memory")
#define PG8_WAIT_L(n) asm volatile("s_waitcnt lgkmcnt(" #n ")" ::: "memory")
#define PG8_BAR __builtin_amdgcn_s_barrier()
#define PG8_SCHED __builtin_amdgcn_sched_barrier(0)
    Unit cur, nxt; int ui = 0;
    if (!S.next(0, cur)) return;
    f32x4 acc[2][2][4][2];
#pragma unroll
    for (int a = 0; a < 2; ++a)
#pragma unroll
        for (int b = 0; b < 2; ++b)
#pragma unroll
            for (int m = 0; m < 4; ++m)
#pragma unroll
                for (int n = 0; n < 2; ++n) acc[a][b][m][n] = (f32x4){0.f, 0.f, 0.f, 0.f};
    bf16x8 At[4][2], B0[2][2], B1[2][2];
    const char* cA = (const char*)g.A + (size_t)cur.pm * tstep; const char* cB = (const char*)g.Bt + (size_t)cur.pn * btstep;
    if constexpr (SP2) {
        PG8_STAGE(PG8_SB(0, 0), cB, voffB); PG8_STAGE(PG8_SB(0, 1), cB + bhstep, voffB); PG8_STAGE(PG8_SA(0, 0), cA, voffA); PG8_STAGE(PG8_SA(0, 1), cA + hstep, voffA);
        if (wr == 1) PG8_BAR;
        PG8_WAIT_V(2); PG8_BAR;
        PG8_STAGE(PG8_SB(1, 0), cB + kstep, voffB); PG8_STAGE(PG8_SA(1, 0), cA + kstep, voffA); PG8_STAGE(PG8_SB(1, 1), cB + bhstep + kstep, voffB);
        PG8_WAIT_V(6); PG8_BAR;
    } else {
        PG8_STAGE(PG8_SB(0, 0), cB, voffB); PG8_STAGE(PG8_SA(0, 0), cA, voffA); PG8_STAGE(PG8_SB(0, 1), cB + bhstep, voffB); PG8_STAGE(PG8_SA(0, 1), cA + hstep, voffA);
        if (wr == 1) PG8_BAR;
        PG8_WAIT_V(4); PG8_BAR;
        PG8_STAGE(PG8_SB(1, 0), cB + kstep, voffB); PG8_STAGE(PG8_SA(1, 0), cA + kstep, voffA); PG8_STAGE(PG8_SB(1, 1), cB + bhstep + kstep, voffB);
        PG8_WAIT_V(6); PG8_BAR;
    }
    for (;;) {
        const bool has_next = S.next(ui + 1, nxt);
        const char* nA = has_next ? (const char*)g.A + (size_t)nxt.pm * tstep : cA; const char* nB = has_next ? (const char*)g.Bt + (size_t)nxt.pn * btstep : cB;
        for (int t = 0; t < nt; t += 2) {
            const bool last = (t == nt - 2);
            const char* a1 = cA + (size_t)(t + 1) * kstep;
            const char* a2 = last ? nA : cA + (size_t)(t + 2) * kstep; const char* b2 = last ? nB : cB + (size_t)(t + 2) * kstep;
            const char* a3 = a2 + kstep; const char* b3 = b2 + kstep;
            if constexpr (SP2) {
            PG8_LDB(B0, 0, 0); PG8_LDB(B1, 0, 1); PG8_SCHED; PG8_LDA(At, 0, 0); PG8_STAGE(PG8_SA(1, 1), a1 + hstep, voffA);
            PG8_WAIT_V(8); PG8_WAIT_L(0); PG8_BAR; PG8_MMA(0, 0, At, B0); PG8_MMA(0, 1, At, B1); PG8_BAR; PG8_SCHED;
            PG8_LDA(At, 0, 1); PG8_STAGE(PG8_SB(0, 0), b2, voffB); PG8_STAGE(PG8_SB(0, 1), b2 + bhstep, voffB); PG8_STAGE(PG8_SA(0, 0), a2, voffA);
            PG8_WAIT_V(8); PG8_WAIT_L(0); PG8_BAR; PG8_MMA(1, 0, At, B0); PG8_MMA(1, 1, At, B1); PG8_BAR; PG8_SCHED;
            PG8_LDB(B0, 1, 0); PG8_LDB(B1, 1, 1); PG8_SCHED; PG8_LDA(At, 1, 0); PG8_STAGE(PG8_SA(0, 1), a2 + hstep, voffA);
            PG8_WAIT_V(8); PG8_WAIT_L(0); PG8_BAR; PG8_MMA(0, 0, At, B0); PG8_MMA(0, 1, At, B1); PG8_BAR; PG8_SCHED;
            PG8_LDA(At, 1, 1); PG8_STAGE(PG8_SB(1, 0), b3, voffB); PG8_STAGE(PG8_SB(1, 1), b3 + bhstep, voffB); PG8_STAGE(PG8_SA(1, 0), a3, voffA);
            PG8_WAIT_V(8); PG8_WAIT_L(0); PG8_BAR; PG8_MMA(1, 0, At, B0); PG8_MMA(1, 1, At, B1); PG8_BAR; PG8_SCHED;
            } else {
            PG8_LDB(B0, 0, 0); PG8_SCHED; PG8_LDA(At, 0, 0); PG8_STAGE(PG8_SA(1, 1), a1 + hstep, voffA);
            PG8_WAIT_L(8); PG8_BAR; PG8_WAIT_L(0); PG8_MMA(0, 0, At, B0); PG8_BAR; PG8_SCHED;
            PG8_LDB(B1, 0, 1); PG8_STAGE(PG8_SB(0, 0), b2, voffB);
            PG8_BAR; PG8_WAIT_L(0); PG8_MMA(0, 1, At, B1); PG8_BAR;
            PG8_LDA(At, 0, 1); PG8_STAGE(PG8_SA(0, 0), a2, voffA);
            PG8_BAR; PG8_WAIT_L(0); PG8_MMA(1, 0, At, B0); PG8_BAR; PG8_SCHED;
            PG8_STAGE(PG8_SB(0, 1), b2 + bhstep, voffB);
            PG8_WAIT_V(6); PG8_BAR; PG8_MMA(1, 1, At, B1); PG8_BAR;
            PG8_LDB(B0, 1, 0); PG8_SCHED; PG8_LDA(At, 1, 0); PG8_STAGE(PG8_SA(0, 1), a2 + hstep, voffA);
            PG8_WAIT_L(8); PG8_BAR; PG8_WAIT_L(0); PG8_MMA(0, 0, At, B0); PG8_BAR; PG8_SCHED;
            PG8_LDB(B1, 1, 1); PG8_STAGE(PG8_SB(1, 0), b3, voffB);
            PG8_BAR; PG8_WAIT_L(0); PG8_MMA(0, 1, At, B1); PG8_BAR;
            PG8_LDA(At, 1, 1); PG8_STAGE(PG8_SA(1, 0), a3, voffA);
            PG8_BAR; PG8_WAIT_L(0); PG8_MMA(1, 0, At, B0); PG8_BAR; PG8_SCHED;
            PG8_STAGE(PG8_SB(1, 1), b3 + bhstep, voffB);
            PG8_WAIT_V(6); PG8_BAR; PG8_MMA(1, 1, At, B1); PG8_BAR;
            }
        }
        if constexpr (ALIGN_EPI) { if (wr == 0) PG8_BAR; }
        E(acc, cur, wr, wc, fr, fq);
        if (!has_next) break;
#pragma unroll
        for (int a = 0; a < 2; ++a)
#pragma unroll
            for (int b = 0; b < 2; ++b)
#pragma unroll
                for (int m = 0; m < 4; ++m)
#pragma unroll
                    for (int n = 0; n < 2; ++n) acc[a][b][m][n] = (f32x4){0.f, 0.f, 0.f, 0.f};
        cur = nxt; cA = nA; cB = nB; ++ui;
        if constexpr (ALIGN_EPI) { if (wr == 1) PG8_BAR; }
    }
    PG8_WAIT_V(0);
    if constexpr (!ALIGN_EPI) { if (wr == 0) PG8_BAR; }
    PG8_BAR;
#undef PG8_SA
#undef PG8_SB
#undef PG8_STAGE
#undef PG8_LDA
#undef PG8_LDB
#undef PG8_MMA
#undef PG8_WAIT_V
#undef PG8_WAIT_L
#undef PG8_BAR
#undef PG8_SCHED
}
}

using pg8::bf16_t; using pg8::f32x4; using pg8::u32x4; using pg8::u32x2; using pg8::bf16x8; using pg8::cvt_pk_bf16; using pg8::Unit;
typedef float f32x16 __attribute__((ext_vector_type(16)));
typedef short s16x4 __attribute__((ext_vector_type(4)));

#define GAS __attribute__((address_space(1)))
#define LAS __attribute__((address_space(3)))
typedef GAS unsigned gu32;
#define RLX_AGENT __ATOMIC_RELAXED, __HIP_MEMORY_SCOPE_AGENT

__device__ __forceinline__ float bf2f(unsigned short h) { return __uint_as_float((unsigned)h << 16); }
__device__ __forceinline__ float bflo(unsigned w) { return __uint_as_float(w << 16); }
__device__ __forceinline__ float bfhi(unsigned w) { return __uint_as_float(w & 0xffff0000u); }
__device__ __forceinline__ u32x2 pack4(f32x4 v) { u32x2 w; w.x = cvt_pk_bf16(v[0], v[1]); w.y = cvt_pk_bf16(v[2], v[3]); return w; }
__device__ __forceinline__ float rstd_of(const float* ss, int r) { return 1.0f / sqrtf(ss[r] * (1.0f / DM) + RMS_EPS); }
template <int NP> __device__ __forceinline__ float rstd_row(const float* ss, int r, int fq) {
    if (NP == 1) return rstd_of(ss, r);
    float q = (ss[(size_t)(4 * fq + 0) * MT + r] + ss[(size_t)(4 * fq + 1) * MT + r]) + (ss[(size_t)(4 * fq + 2) * MT + r] + ss[(size_t)(4 * fq + 3) * MT + r]);
    q += __shfl_xor(q, 16); q += __shfl_xor(q, 32);
    return 1.0f / sqrtf(q * (1.0f / DM) + RMS_EPS);
}
__device__ __forceinline__ float sigmoidf_(float v) { return __builtin_amdgcn_rcpf(1.0f + __builtin_amdgcn_exp2f(-1.4426950408889634f * v)); }

template <int NP> struct EpiUp {
    static constexpr int PERM = 1;
    bf16_t* H; const float* ss;
    __device__ __forceinline__ void operator()(const f32x4 (&acc)[2][2][4][2], const Unit& u, int wr, int wc, int fr, int fq) const {
        const int row0 = u.pm * 256 + wr * 64 + fr, col0 = u.pn * 128 + wc * 32 + 8 * fq;
#pragma unroll
        for (int ai = 0; ai < 2; ++ai)
#pragma unroll
            for (int m = 0; m < 4; ++m) {
                const int r = row0 + ai * 128 + m * 16; const float rs = rstd_row<NP>(ss, r, fq);
                f32x4 h[2];
#pragma unroll
                for (int n = 0; n < 2; ++n) { const f32x4 gt = acc[ai][0][m][n] * rs, up = acc[ai][1][m][n] * rs;
#pragma unroll
                    for (int e = 0; e < 4; ++e) h[n][e] = gt[e] * sigmoidf_(gt[e]) * up[e]; }
                u32x4 w; w.x = cvt_pk_bf16(h[0][0], h[0][1]); w.y = cvt_pk_bf16(h[0][2], h[0][3]); w.z = cvt_pk_bf16(h[1][0], h[1][1]); w.w = cvt_pk_bf16(h[1][2], h[1][3]);
                *(u32x4*)(H + (size_t)r * FF + col0) = w;
            }
    }
};

template <bool SRCF, bool DSTF> struct EpiRes {
    static constexpr int PERM = 1;
    const float* srcf; const bf16_t* srcb; float* dstf; bf16_t* dstb; float* ss_out; float scale;
    __device__ __forceinline__ void operator()(const f32x4 (&acc)[2][2][4][2], const Unit& u, int wr, int wc, int fr, int fq) const {
        const int row0 = u.pm * 256 + wr * 64 + fr, col0 = u.pn * 256 + wc * 32 + 8 * fq;
#pragma unroll
        for (int ai = 0; ai < 2; ++ai)
#pragma unroll
            for (int m = 0; m < 4; ++m) {
                const int r = row0 + ai * 128 + m * 16; float q = 0.f;
#pragma unroll
                for (int bj = 0; bj < 2; ++bj) { const size_t o = (size_t)r * DM + col0 + bj * 128; f32x4 x0, x1;
                    if (SRCF) { x0 = *(const f32x4*)(srcf + o); x1 = *(const f32x4*)(srcf + o + 4); }
                    else { const u32x4 w = *(const u32x4*)(srcb + o); x0 = (f32x4){bflo(w.x), bfhi(w.x), bflo(w.y), bfhi(w.y)}; x1 = (f32x4){bflo(w.z), bfhi(w.z), bflo(w.w), bfhi(w.w)}; }
                    const f32x4 v0 = x0 + acc[ai][bj][m][0] * scale, v1 = x1 + acc[ai][bj][m][1] * scale;
                    if (DSTF) { *(f32x4*)(dstf + o) = v0; *(f32x4*)(dstf + o + 4) = v1; }
                    else { u32x4 w; w.x = cvt_pk_bf16(v0[0], v0[1]); w.y = cvt_pk_bf16(v0[2], v0[3]); w.z = cvt_pk_bf16(v1[0], v1[1]); w.w = cvt_pk_bf16(v1[2], v1[3]); *(u32x4*)(dstb + o) = w; }
                    q += ((v0[0] * v0[0] + v0[1] * v0[1]) + (v0[2] * v0[2] + v0[3] * v0[3])) + ((v1[0] * v1[0] + v1[1] * v1[1]) + (v1[2] * v1[2] + v1[3] * v1[3])); }
                q += __shfl_xor(q, 16); q += __shfl_xor(q, 32);
                if (fq == 0) ss_out[(size_t)(u.pn * 4 + wc) * MT + r] = q;
            }
    }
};

__device__ __forceinline__ u32x4 pair16(u32x2 w0, u32x2 w1) {
    const auto rx = __builtin_amdgcn_permlane16_swap(w0.x, w1.x, false, false), ry = __builtin_amdgcn_permlane16_swap(w0.y, w1.y, false, false);
    return (u32x4){rx[0], ry[0], rx[1], ry[1]};
}

__device__ __forceinline__ void sincos_rev(float ang, float& s, float& c) {
    const float C_hi = 0.15915494f, C_lo = 6.4206383e-09f;
    const float p = ang * C_hi; float e = __builtin_fmaf(ang, C_hi, -p); e = __builtin_fmaf(ang, C_lo, e);
    const float f = __builtin_amdgcn_fractf(p) + e;
    s = __builtin_amdgcn_sinf(f); c = __builtin_amdgcn_cosf(f);
}

struct EpiIn {
    static constexpr int PERM = 2;
    const float* ss; bf16_t* U; bf16_t* QKV; bf16_t* G; float* out;
    __device__ __forceinline__ void operator()(const f32x4 (&acc)[2][2][4][2], const Unit& u, int wr, int wc, int fr, int fq) const {
        const int row0 = u.pm * 256 + wr * 64 + fr;
        const int hsel = wc >> 1, dlo = 16 * (wc & 1) + 4 * fq;
        const int cb = 64 * hsel + dlo;
        const int cst = (fq & 1) ? cb + 28 : cb;
        const int pn = u.pn;
        if (pn < 2) {
#pragma unroll
            for (int ai = 0; ai < 2; ++ai)
#pragma unroll
                for (int m = 0; m < 4; ++m) {
                    const int r = row0 + ai * 128 + m * 16; const float rs = rstd_row<16>(ss, r, fq);
                    const int t = r & (SEQ - 1), b = r >> 11; float* po = nullptr;
                    if (t >= SEQ - 15) po = out + O_POOLP + (size_t)(b * 15 + (t - (SEQ - 15))) * PW + pn * 256 + cb;
#pragma unroll
                    for (int bj = 0; bj < 2; ++bj) { const f32x4 v0 = acc[ai][bj][m][0] * rs, v1 = acc[ai][bj][m][1] * rs;
                        *(u32x4*)(U + (size_t)r * PW + pn * 256 + 128 * bj + cst) = pair16(pack4(v0), pack4(v1));
                        if (po) { *(f32x4*)(po + 128 * bj) = v0; *(f32x4*)(po + 128 * bj + 32) = v1; } }
                }
        } else if (pn < 11) {
            const int j = pn - 2, g = j / 3, which = j - 3 * g;
            float inv[4];
#pragma unroll
            for (int e = 0; e < 4; ++e) inv[e] = __builtin_amdgcn_exp2f(-(float)(dlo + e) * (13.287712379549449f / 32.0f));
#pragma unroll
            for (int ai = 0; ai < 2; ++ai)
#pragma unroll
                for (int m = 0; m < 4; ++m) {
                    const int r = row0 + ai * 128 + m * 16; const float rs = rstd_row<16>(ss, r, fq);
                    bf16_t* qrow = QKV + (size_t)r * QKVW + g * 768 + which * 256 + cst;
                    if (which == 2) {
#pragma unroll
                        for (int bj = 0; bj < 2; ++bj) *(u32x4*)(qrow + 128 * bj) = pair16(pack4(acc[ai][bj][m][0] * rs), pack4(acc[ai][bj][m][1] * rs));
                    } else {
                        const float pos = (float)(r & (SEQ - 1));
                        f32x4 cs, sn;
#pragma unroll
                        for (int e = 0; e < 4; ++e) { float s_, c_; sincos_rev(pos * inv[e], s_, c_); cs[e] = c_; sn[e] = s_; }
                        const float sc = (which == 0) ? rs * C2 : rs;
#pragma unroll
                        for (int bj = 0; bj < 2; ++bj) { const f32x4 t1 = acc[ai][bj][m][0] * sc, t2 = acc[ai][bj][m][1] * sc;
                            *(u32x4*)(qrow + 128 * bj) = pair16(pack4(t1 * cs - t2 * sn), pack4(t1 * sn + t2 * cs)); }
                    }
                }
        } else {
#pragma unroll
            for (int ai = 0; ai < 2; ++ai)
#pragma unroll
                for (int m = 0; m < 4; ++m) {
                    const int r = row0 + ai * 128 + m * 16; const float rs = rstd_row<16>(ss, r, fq);
#pragma unroll
                    for (int bj = 0; bj < 2; ++bj) { const f32x4 v0 = acc[ai][bj][m][0] * rs, v1 = acc[ai][bj][m][1] * rs; f32x4 s0, s1;
#pragma unroll
                        for (int e = 0; e < 4; ++e) { s0[e] = sigmoidf_(v0[e]); s1[e] = sigmoidf_(v1[e]); }
                        *(u32x4*)(G + (size_t)r * GW + (pn - 11) * 256 + 128 * bj + cst) = pair16(pack4(s0), pack4(s1)); }
                }
        }
    }
};

template <int SECOND> struct EpiBr {
    static constexpr int PERM = 1;
    const bf16_t* G; bf16_t* T1; bf16_t* MG;
    __device__ __forceinline__ void operator()(const f32x4 (&acc)[2][2][4][2], const Unit& u, int wr, int wc, int fr, int fq) const {
        const int row0 = u.pm * 256 + wr * 64 + fr, col0 = u.pn * 256 + wc * 32 + 8 * fq;
#pragma unroll
        for (int ai = 0; ai < 2; ++ai)
#pragma unroll
            for (int m = 0; m < 4; ++m) {
                const int r = row0 + ai * 128 + m * 16;
#pragma unroll
                for (int bj = 0; bj < 2; ++bj) { const int c = col0 + bj * 128;
                    const u32x4 gw = *(const u32x4*)(G + (size_t)r * GW + SECOND * DM + c);
                    const f32x4 a0 = acc[ai][bj][m][0], a1 = acc[ai][bj][m][1];
                    float v[8] = {a0[0] * bflo(gw.x), a0[1] * bfhi(gw.x), a0[2] * bflo(gw.y), a0[3] * bfhi(gw.y), a1[0] * bflo(gw.z), a1[1] * bfhi(gw.z), a1[2] * bflo(gw.w), a1[3] * bfhi(gw.w)};
                    if (SECOND) { const u32x4 tw = *(const u32x4*)(T1 + (size_t)r * DM + c);
                        v[0] += bflo(tw.x); v[1] += bfhi(tw.x); v[2] += bflo(tw.y); v[3] += bfhi(tw.y); v[4] += bflo(tw.z); v[5] += bfhi(tw.z); v[6] += bflo(tw.w); v[7] += bfhi(tw.w); }
                    u32x4 w; w.x = cvt_pk_bf16(v[0], v[1]); w.y = cvt_pk_bf16(v[2], v[3]); w.z = cvt_pk_bf16(v[4], v[5]); w.w = cvt_pk_bf16(v[6], v[7]);
                    *(u32x4*)((SECOND ? MG : T1) + (size_t)r * DM + c) = w; }
            }
    }
};

constexpr size_t MiB = 1u << 20;
constexpr size_t WS_CTL = 0, CTL_ZERO_BYTES = 1 * MiB;
constexpr int CW_BAR = 4096;
constexpr int CW_SS = 16384;
static_assert((CW_SS + MT) * 4 <= (int)CTL_ZERO_BYTES, "ctl");
constexpr size_t WS_W1UP = 1 * MiB;
constexpr size_t WS_W1DN = WS_W1UP + (size_t)2 * FF * DM * 2;
constexpr size_t WS_WIN = WS_W1DN + (size_t)DM * FF * 2;
constexpr size_t WS_WCOMB = WS_WIN + (size_t)INW * DM * 2;
constexpr size_t WS_WAB = WS_WCOMB + (size_t)DM * PW * 2;
constexpr size_t WS_WO = WS_WAB + (size_t)DM * AW * 2;
constexpr size_t WS_W2UP = WS_WO + (size_t)DM * DM * 2;
constexpr size_t WS_W2DN = WS_W2UP + (size_t)2 * FF * DM * 2;
constexpr size_t WS_XS = WS_W2DN + (size_t)DM * FF * 2;
constexpr size_t WS_XB = WS_XS + (size_t)256 * DM * 4;
constexpr size_t OG_BYTES = (size_t)MT * 768 * 2, LSE_BYTES = (size_t)MT * 12 * 4;
static_assert(OG_BYTES + LSE_BYTES <= (size_t)MP * DM * 4, "OG/LSE fit in the y_prompt region");
constexpr size_t WS_Z = WS_XB + (size_t)MT * DM * 2;
constexpr size_t WS_H = WS_Z;
constexpr size_t WS_U = WS_Z;
constexpr size_t WS_QKV = WS_U + (size_t)MT * PW * 2;
constexpr size_t WS_T1 = WS_QKV, WS_MG = WS_QKV + (size_t)MT * DM * 2;
constexpr size_t WS_G = WS_QKV + (size_t)MT * QKVW * 2;
static_assert(WS_MG + (size_t)MT * DM * 2 <= WS_G, "T1/MG overlay fits in QKV");
constexpr size_t WS_P = WS_G + (size_t)MT * GW * 2;
static_assert(WS_H + (size_t)MT * FF * 2 <= WS_P, "H overlay fits in Z");
constexpr size_t WS_ATT = WS_P + (size_t)MT * PW * 2;
constexpr size_t WS_SSP = WS_ATT + (size_t)MT * AW * 2;
constexpr size_t SSP_STRIDE = (size_t)16 * MT;
constexpr size_t WS_SSS = WS_SSP + 3 * SSP_STRIDE * 4;
constexpr size_t WS_END = WS_SSS + 3 * 64 * 32 * 4;

constexpr int RING_OFF = 0, RING_BYTES = 131072;
constexpr int LDSCTL_OFF = RING_BYTES, MISC_OFF = LDSCTL_OFF + 320;
constexpr int LDS_BYTES = 147456;
constexpr int NWAVES = 8;

#define XB_TMO      128
#define XB_XCNT(j)  (256  + 64 * (j))
#define XB_XSUB(j)  (1280 + 64 * (j))
#define XB_XGEN(j)  (2304 + 64 * (j))
#define XB_TOP      3328
#define XB_TOPGEN   3392
#define XCD_BAR_WORDS 3456
#define XB_SPIN_CAP (1u << 18)
__device__ __forceinline__ unsigned xb_ld(unsigned* p)              { return __hip_atomic_load(p, __ATOMIC_RELAXED, __HIP_MEMORY_SCOPE_AGENT); }
__device__ __forceinline__ unsigned xb_add(unsigned* p, unsigned v) { return __hip_atomic_fetch_add(p, v, __ATOMIC_RELAXED, __HIP_MEMORY_SCOPE_AGENT); }
__device__ __forceinline__ unsigned xb_xcc_id() { return (unsigned)__builtin_amdgcn_s_getreg((3 << 11) | 20) & 0xFu; }
#define XB_SPIN(cond, bar) do { unsigned _sp = 0; while (cond) { __builtin_amdgcn_s_sleep(1); \
    if ((++_sp & 255u) == 0u) { if (xb_ld(&(bar)[XB_TMO])) break; if (_sp > XB_SPIN_CAP) { atomicAdd(&(bar)[XB_TMO], 1u); break; } } } } while (0)
struct XcdBarrier { unsigned* bar; unsigned x; volatile LAS unsigned* st; };
__device__ __forceinline__ XcdBarrier xcd_barrier_post(unsigned* bar, volatile LAS unsigned* st) {
    XcdBarrier b; b.bar = bar; b.x = xb_xcc_id(); b.st = st;
    if (threadIdx.x == 0) (void)xb_add(&bar[XB_XCNT(b.x)], 1u);
    return b;
}
__device__ __forceinline__ void xcd_barrier_complete(unsigned* bar, unsigned x, unsigned& nloc, unsigned& nx) {
    const unsigned G = gridDim.x * gridDim.y * gridDim.z;
    unsigned sum, cnt, mine, sp = 0u;
    for (;;) {
        sum = 0u; cnt = 0u; mine = 0u;
#pragma unroll
        for (unsigned j = 0; j < 16; ++j) { const unsigned c = xb_ld(&bar[XB_XCNT(j)]); sum += c; cnt += (c > 0u) ? 1u : 0u; mine = (j == x) ? c : mine; }
        if (sum == G) break;
        __builtin_amdgcn_s_sleep(1);
        if ((++sp & 255u) == 0u) { if (xb_ld(&bar[XB_TMO])) break; if (sp > XB_SPIN_CAP) { atomicAdd(&bar[XB_TMO], 1u); break; } }
    }
    nloc = mine > 0u ? mine : 1u; nx = cnt > 0u ? cnt : 1u;
}
__device__ __forceinline__ void xcd_barrier(const XcdBarrier& b) {
    asm volatile("s_waitcnt vmcnt(0)" ::: "memory");
    __syncthreads();
    if (threadIdx.x == 0) {
        unsigned* bar = b.bar;
        __builtin_amdgcn_s_waitcnt(0);
        unsigned nloc = b.st[0], nx = b.st[1];
        if (nloc == 0u) { xcd_barrier_complete(bar, b.x, nloc, nx); b.st[0] = nloc; b.st[1] = nx; }
        const unsigned old = xb_add(&bar[XB_XSUB(b.x)], 1u);
        const unsigned gen = old / nloc;
        if (old + 1u == (gen + 1u) * nloc) {
            __builtin_amdgcn_fence(__ATOMIC_RELEASE, "agent");
            asm volatile("s_waitcnt vmcnt(0)" ::: "memory");
            const unsigned og = xb_add(&bar[XB_TOP], 1u);
            const unsigned tg = og / nx;
            if (og + 1u == (tg + 1u) * nx) xb_add(&bar[XB_TOPGEN], 1u);
            else XB_SPIN(xb_ld(&bar[XB_TOPGEN]) == tg, bar);
            __builtin_amdgcn_fence(__ATOMIC_ACQUIRE, "agent");
            xb_add(&bar[XB_XGEN(b.x)], 1u);
            asm volatile("s_waitcnt vmcnt(0)" ::: "memory");
        } else {
            XB_SPIN(xb_ld(&bar[XB_XGEN(b.x)]) == gen, bar);
            __builtin_amdgcn_fence(__ATOMIC_ACQUIRE, "agent");
            asm volatile("s_waitcnt vmcnt(0)" ::: "memory");
        }
    }
    __syncthreads();
}

struct Args { const float* in[22]; float* out; unsigned char* ws; int ph_lo, ph_hi; };
struct Frame {
    LAS unsigned char* lds; int tid, lane, wave, vcu, G;
};
#define LDS_WAIT() asm volatile("s_waitcnt lgkmcnt(0)" ::: "memory")


template <int NF> __device__ __forceinline__ void sk_mma(const bf16_t* A, int lda, const bf16_t* const (&Bp)[NF], int ldb, int k0, int k1, f32x4 (&acc)[2][NF], int lane) {
    const int fr = lane & 15, fq = lane >> 4;
    const bf16_t* a0 = A + (size_t)fr * lda + 8 * fq; const bf16_t* a1 = a0 + (size_t)16 * lda;
    const bf16_t* b[NF];
#pragma unroll
    for (int n = 0; n < NF; ++n) b[n] = Bp[n] + (size_t)fr * ldb + 8 * fq;
#pragma unroll 4
    for (int k = k0; k < k1; k += 32) {
        const bf16x8 av0 = *(const bf16x8*)(a0 + k), av1 = *(const bf16x8*)(a1 + k);
#pragma unroll
        for (int n = 0; n < NF; ++n) { const bf16x8 bv = *(const bf16x8*)(b[n] + k);
            acc[0][n] = __builtin_amdgcn_mfma_f32_16x16x32_bf16(bv, av0, acc[0][n], 0, 0, 0);
            acc[1][n] = __builtin_amdgcn_mfma_f32_16x16x32_bf16(bv, av1, acc[1][n], 0, 0, 0); }
    }
}
__device__ __forceinline__ void sk_rstd64(const float* sss, int fr, int fq, float& r0, float& r1) {
    float a = 0.f, b = 0.f;
#pragma unroll
    for (int k = 0; k < 16; ++k) { a += sss[(16 * fq + k) * 32 + fr]; b += sss[(16 * fq + k) * 32 + fr + 16]; }
    a += __shfl_xor(a, 16); a += __shfl_xor(a, 32); b += __shfl_xor(b, 16); b += __shfl_xor(b, 32);
    r0 = 1.0f / sqrtf(a * (1.0f / DM) + RMS_EPS); r1 = 1.0f / sqrtf(b * (1.0f / DM) + RMS_EPS);
}
__device__ __forceinline__ void sk_up(const Frame& F, const bf16_t* XB, const bf16_t* Wup, bf16_t* H, const float* ss0, const float* sss) {
    const int gw = F.vcu * NWAVES + F.wave, NGW = F.G * NWAVES, lane = F.lane, fr = lane & 15, fq = lane >> 4;
    for (int it = gw; it < FF / 16; it += NGW) {
        float rs[2];
        if (sss) sk_rstd64(sss, fr, fq, rs[0], rs[1]); else { rs[0] = rstd_of(ss0, MP + fr); rs[1] = rstd_of(ss0, MP + 16 + fr); }
        f32x4 acc[2][2] = {};
        const bf16_t* const Bp[2] = {Wup + (size_t)(16 * it) * DM, Wup + (size_t)(FF + 16 * it) * DM};
        sk_mma<2>(XB + (size_t)MP * DM, DM, Bp, DM, 0, DM, acc, lane);
#pragma unroll
        for (int m = 0; m < 2; ++m) { const f32x4 gt = acc[m][0] * rs[m], up = acc[m][1] * rs[m]; f32x4 h;
#pragma unroll
            for (int e = 0; e < 4; ++e) h[e] = gt[e] * sigmoidf_(gt[e]) * up[e];
            *(u32x2*)(H + (size_t)(MP + 16 * m + fr) * FF + 16 * it + 4 * fq) = pack4(h); }
    }
}
template <int KS> __device__ __forceinline__ void sk_res(const Frame& F, const bf16_t* A, int K, const bf16_t* Wt, float* XS, bf16_t* XBs, float* sss_out, float scale) {
    const int nwg = (64 * KS + NWAVES - 1) / NWAVES;
    if (F.vcu >= nwg) return;
    const int gw = F.vcu * NWAVES + F.wave, lane = F.lane, fr = lane & 15, fq = lane >> 4, it = gw / KS, sl = gw % KS;
    f32x4 acc[2][1] = {};
    if (it < 64) { const bf16_t* const Bp[1] = {Wt + (size_t)(16 * it) * K}; const int kc = K / KS; sk_mma<1>(A, K, Bp, K, sl * kc, (sl + 1) * kc, acc, lane); }
    LAS f32x4* red = (LAS f32x4*)(F.lds + 98304) + F.wave * 128;
    if (KS > 1) { red[lane] = acc[0][0]; red[64 + lane] = acc[1][0]; __syncthreads(); }
    if (it < 64 && sl == 0) {
#pragma unroll
        for (int k = 1; k < KS; ++k) { acc[0][0] += red[k * 128 + lane]; acc[1][0] += red[k * 128 + 64 + lane]; }
#pragma unroll
        for (int m = 0; m < 2; ++m) { const int row = 16 * m + fr; const size_t o = (size_t)row * DM + 16 * it + 4 * fq;
            const f32x4 v = *(const f32x4*)(XS + o) + acc[m][0] * scale; *(f32x4*)(XS + o) = v;
            if (XBs) *(u32x2*)(XBs + o) = pack4(v);
            float q = (v[0] * v[0] + v[1] * v[1]) + (v[2] * v[2] + v[3] * v[3]); q += __shfl_xor(q, 16); q += __shfl_xor(q, 32);
            if (fq == 0) sss_out[it * 32 + row] = q; }
    }
    if (KS > 1) __syncthreads();
}
__device__ __forceinline__ void sk_in(const Frame& F, const bf16_t* XB, const bf16_t* Win, const float* sss, bf16_t* U, bf16_t* QKV, bf16_t* G, float* out) {
    const int gw = F.vcu * NWAVES + F.wave, NGW = F.G * NWAVES, lane = F.lane, fr = lane & 15, fq = lane >> 4;
    for (int it = gw; it < INW / 32; it += NGW) {
        const int blk = it >> 1, c0 = 64 * blk + 16 * (it & 1);
        float rs[2]; sk_rstd64(sss, fr, fq, rs[0], rs[1]);
        f32x4 acc[2][2] = {};
        const bf16_t* const Bp[2] = {Win + (size_t)c0 * DM, Win + (size_t)(c0 + 32) * DM};
        sk_mma<2>(XB + (size_t)MP * DM, DM, Bp, DM, 0, DM, acc, lane);
        const int cl = 16 * (it & 1) + 4 * fq;
#pragma unroll
        for (int m = 0; m < 2; ++m) {
            const int n = 16 * m + fr; const size_t r = (size_t)MP + n; const f32x4 z0 = acc[m][0] * rs[m], z1 = acc[m][1] * rs[m];
            if (blk < 8) {
                const int c = 64 * blk + cl; float* po = out + O_POOLS + (size_t)(n * 15 + 14) * PW;
                *(u32x2*)(U + r * PW + c) = pack4(z0); *(u32x2*)(U + r * PW + c + 32) = pack4(z1); *(f32x4*)(po + c) = z0; *(f32x4*)(po + c + 32) = z1;
            } else if (blk < 44) {
                const int j = blk - 8, g = j / 12, rem = j - 12 * g, which = rem >> 2, h = rem & 3, W = 128 << (2 * g);
                bf16_t* qrow = QKV + r * QKVW + g * 768 + which * 256 + h * 64 + cl;
                const size_t oks = (g == 0) ? O_KV128S : (g == 1) ? O_KV512S : O_KV2048S;
                float* kvo = out + oks + ((size_t)(n * W + (W - 1)) * 2 + (which - 1)) * 256 + h * 64 + cl;
                if (which == 2) { *(u32x2*)qrow = pack4(z0); *(u32x2*)(qrow + 32) = pack4(z1); *(f32x4*)kvo = z0; *(f32x4*)(kvo + 32) = z1; }
                else {
                    f32x4 cs, sn;
#pragma unroll
                    for (int e = 0; e < 4; ++e) { float s_, c_; sincos_rev((float)PAST * __builtin_amdgcn_exp2f(-(float)(cl + e) * (13.287712379549449f / 32.0f)), s_, c_); cs[e] = c_; sn[e] = s_; }
                    const float sc = (which == 0) ? C2 : 1.0f; const f32x4 t1 = z0 * sc, t2 = z1 * sc, o1 = t1 * cs - t2 * sn, o2 = t1 * sn + t2 * cs;
                    *(u32x2*)qrow = pack4(o1); *(u32x2*)(qrow + 32) = pack4(o2);
                    if (which == 1) { *(f32x4*)kvo = o1; *(f32x4*)(kvo + 32) = o2; }
                }
            } else {
                const int c = 64 * (blk - 44) + cl; f32x4 s0, s1;
#pragma unroll
                for (int e = 0; e < 4; ++e) { s0[e] = sigmoidf_(z0[e]); s1[e] = sigmoidf_(z1[e]); }
                *(u32x2*)(G + r * GW + c) = pack4(s0); *(u32x2*)(G + r * GW + c + 32) = pack4(s1);
            }
        }
    }
}
__device__ __forceinline__ void sk_br(const Frame& F, const bf16_t* P, const bf16_t* ATT, const bf16_t* Wcomb, const bf16_t* Wab, const bf16_t* G, bf16_t* MG) {
    const int gw = F.vcu * NWAVES + F.wave, NGW = F.G * NWAVES, lane = F.lane, fr = lane & 15, fq = lane >> 4;
    for (int it = gw; it < 64; it += NGW) {
        f32x4 ap[2][1] = {}, aa[2][1] = {};
        { const bf16_t* const Bp[1] = {Wcomb + (size_t)(16 * it) * PW}; sk_mma<1>(P + (size_t)MP * PW, PW, Bp, PW, 0, PW, ap, lane); }
        { const bf16_t* const Bp[1] = {Wab + (size_t)(16 * it) * AW}; sk_mma<1>(ATT + (size_t)MP * AW, AW, Bp, AW, 0, AW, aa, lane); }
#pragma unroll
        for (int m = 0; m < 2; ++m) { const size_t r = (size_t)MP + 16 * m + fr; const int c = 16 * it + 4 * fq;
            const u32x2 gp = *(const u32x2*)(G + r * GW + c), ga = *(const u32x2*)(G + r * GW + DM + c);
            f32x4 v; v[0] = ap[m][0][0] * bflo(gp.x) + aa[m][0][0] * bflo(ga.x); v[1] = ap[m][0][1] * bfhi(gp.x) + aa[m][0][1] * bfhi(ga.x);
            v[2] = ap[m][0][2] * bflo(gp.y) + aa[m][0][2] * bflo(ga.y); v[3] = ap[m][0][3] * bfhi(gp.y) + aa[m][0][3] * bfhi(ga.y);
            *(u32x2*)(MG + r * DM + c) = pack4(v); }
    }
}

__device__ __forceinline__ void p0_transpose_item(const float* W, const float* gain, int K, int N, bf16_t* WT, int row_off, LAS float* scr, int item, int lane) {
    const int nblk = N / 32, kb = item / nblk, nb = item % nblk, k0 = 64 * kb, n0 = 32 * nb;
    float tv[32];
#pragma unroll
    for (int i = 0; i < 32; ++i) tv[i] = W[(size_t)(k0 + 2 * i + (lane >> 5)) * N + n0 + (lane & 31)];
    if (gain) {
#pragma unroll
        for (int i = 0; i < 32; ++i) tv[i] *= gain[k0 + 2 * i + (lane >> 5)]; }
#pragma unroll
    for (int i = 0; i < 32; ++i) scr[(2 * i + (lane >> 5)) * 33 + (lane & 31)] = tv[i];
    LDS_WAIT(); asm volatile("" ::: "memory");
    const int c = lane & 7;
#pragma unroll
    for (int j = 0; j < 4; ++j) { const int n = (lane >> 3) + 8 * j; const LAS float* s = scr + (8 * c) * 33 + n;
        u32x4 o; o.x = cvt_pk_bf16(s[0 * 33], s[1 * 33]); o.y = cvt_pk_bf16(s[2 * 33], s[3 * 33]); o.z = cvt_pk_bf16(s[4 * 33], s[5 * 33]); o.w = cvt_pk_bf16(s[6 * 33], s[7 * 33]);
        *(u32x4*)(WT + (size_t)(row_off + n0 + n) * K + k0 + 8 * c) = o; }
    LDS_WAIT(); asm volatile("" ::: "memory");
}
__device__ __forceinline__ float wave_sum(float v) {
#pragma unroll
    for (int o = 1; o < 64; o <<= 1) v += __shfl_xor(v, o);
    return v;
}

template <int PARTS> __device__ __forceinline__ void p0_prologue(const Frame& F, const Args& a) {
    unsigned char* ws = a.ws;
    LAS float* scr = (LAS float*)(F.lds + RING_OFF + F.wave * 16384);
    const int gw = F.vcu * NWAVES + F.wave, NGW = F.G * NWAVES;
    constexpr int I_UP = (DM / 64) * (FF / 32), I_DN = (FF / 64) * (DM / 32), I_IN = (DM / 64) * (INW / 32), I_AB = (AW / 64) * (DM / 32), I_O = (DM / 64) * (DM / 32), I_CMB = 1024;
    constexpr int NITEMS = 4 * I_UP + 2 * I_DN + I_IN + I_AB + I_O + I_CMB;
    if (PARTS & 1) for (int it = gw; it < NITEMS; it += NGW) {
        int r = it;
        if (r < I_UP) { p0_transpose_item(a.in[7], a.in[6], DM, FF, (bf16_t*)(ws + WS_W1UP), 0, scr, r, F.lane); continue; } r -= I_UP;
        if (r < I_UP) { p0_transpose_item(a.in[8], a.in[6], DM, FF, (bf16_t*)(ws + WS_W1UP), FF, scr, r, F.lane); continue; } r -= I_UP;
        if (r < I_DN) { p0_transpose_item(a.in[9], nullptr, FF, DM, (bf16_t*)(ws + WS_W1DN), 0, scr, r, F.lane); continue; } r -= I_DN;
        if (r < I_IN) { p0_transpose_item(a.in[11], a.in[10], DM, INW, (bf16_t*)(ws + WS_WIN), 0, scr, r, F.lane); continue; } r -= I_IN;
        if (r < I_AB) { p0_transpose_item(a.in[15], nullptr, AW, DM, (bf16_t*)(ws + WS_WAB), 0, scr, r, F.lane); continue; } r -= I_AB;
        if (r < I_O) { p0_transpose_item(a.in[16], nullptr, DM, DM, (bf16_t*)(ws + WS_WO), 0, scr, r, F.lane); continue; } r -= I_O;
        if (r < I_UP) { p0_transpose_item(a.in[18], a.in[17], DM, FF, (bf16_t*)(ws + WS_W2UP), 0, scr, r, F.lane); continue; } r -= I_UP;
        if (r < I_UP) { p0_transpose_item(a.in[19], a.in[17], DM, FF, (bf16_t*)(ws + WS_W2UP), FF, scr, r, F.lane); continue; } r -= I_UP;
        if (r < I_DN) { p0_transpose_item(a.in[20], nullptr, FF, DM, (bf16_t*)(ws + WS_W2DN), 0, scr, r, F.lane); continue; } r -= I_DN;
        {
            const int nb = r & 15, kc = r >> 4, k0 = kc * 8, g = k0 >> 7, c0 = k0 & 127, n = nb * 64 + F.lane;
            const float* wgrp = a.in[12] + (size_t)(g * 128 + c0) * 128; const float* scl = a.in[13] + g * 128; const float* wpb = a.in[14] + (size_t)(g * 128) * DM + n;
            float ac[8] = {0.f, 0.f, 0.f, 0.f, 0.f, 0.f, 0.f, 0.f};
#pragma unroll 1
            for (int d0 = 0; d0 < 128; d0 += 16) { float wv[16];
#pragma unroll
                for (int j = 0; j < 16; ++j) wv[j] = wpb[(size_t)(d0 + j) * DM];
#pragma unroll
                for (int j = 0; j < 16; ++j) { const float w2 = wv[j] * scl[d0 + j];
#pragma unroll
                    for (int i = 0; i < 8; ++i) ac[i] += wgrp[i * 128 + d0 + j] * w2; } }
            u32x4 o; o.x = cvt_pk_bf16(ac[0], ac[1]); o.y = cvt_pk_bf16(ac[2], ac[3]); o.z = cvt_pk_bf16(ac[4], ac[5]); o.w = cvt_pk_bf16(ac[6], ac[7]);
            *(u32x4*)((bf16_t*)(ws + WS_WCOMB) + (size_t)n * PW + k0) = o;
        }
    }
    float* ss0 = (float*)(ws + WS_CTL) + CW_SS;
    if (PARTS & 2) for (int m = gw; m < MP + NS; m += NGW) {
        const float* xr = (m < MP) ? a.in[0] + (size_t)m * DM : a.in[1] + (size_t)(m - MP) * DM;
        const f32x4* x4 = (const f32x4*)xr + F.lane; f32x4 v[4]; float s = 0.f;
#pragma unroll
        for (int j = 0; j < 4; ++j) { v[j] = x4[64 * j]; s += (v[j].x * v[j].x + v[j].y * v[j].y) + (v[j].z * v[j].z + v[j].w * v[j].w); }
        s = wave_sum(s);
        u32x2* o8 = (u32x2*)((bf16_t*)(ws + WS_XB) + (size_t)m * DM) + F.lane;
#pragma unroll
        for (int j = 0; j < 4; ++j) o8[64 * j] = pack4(v[j]);
        if (m >= MP) { f32x4* xs4 = (f32x4*)((float*)(ws + WS_XS) + (size_t)(m - MP) * DM) + F.lane;
#pragma unroll
            for (int j = 0; j < 4; ++j) xs4[64 * j] = v[j]; }
        if (F.lane == 0) ss0[m] = s;
    }
    const size_t gt = (size_t)F.vcu * (NWAVES * 64) + F.tid, NT = (size_t)F.G * NWAVES * 64;
#define COPY_SHIFT(src, dstoff, ROWS, RW4) if (PARTS & 4) do { const f32x4* s4 = (const f32x4*)(src); f32x4* d4 = (f32x4*)(a.out + (dstoff)); \
        const size_t per = (size_t)((ROWS) - 1) * (RW4), tot = (size_t)NS * per; \
        for (size_t i = gt; i < tot; i += NT) { const size_t n = i / per, rem = i - n * per; d4[n * (size_t)(ROWS) * (RW4) + rem] = s4[n * (size_t)(ROWS) * (RW4) + (RW4) + rem]; } } while (0)
    COPY_SHIFT(a.in[5], O_KV2048S, 2048, 128);
    COPY_SHIFT(a.in[4], O_KV512S, 512, 128);
    COPY_SHIFT(a.in[3], O_KV128S, 128, 128);
    COPY_SHIFT(a.in[2], O_POOLS, 15, 128);
#undef COPY_SHIFT
}

namespace att {
__device__ __forceinline__ int crow(int r, int hi) { return (r & 3) + 8 * (r >> 2) + 4 * hi; }
typedef short v4i16_t __attribute__((ext_vector_type(4)));
__device__ __forceinline__ s16x4 vtr(LAS const unsigned char* p) { return __builtin_bit_cast(s16x4, __builtin_amdgcn_ds_read_tr16_b64_v4i16((LAS v4i16_t*)p)); }
__device__ __forceinline__ float swapmax(float m) { auto rr = __builtin_amdgcn_permlane32_swap(__float_as_uint(m), __float_as_uint(m), false, false); return fmaxf(__uint_as_float(rr[0]), __uint_as_float(rr[1])); }
__device__ __forceinline__ float swapsum(float m) { auto rr = __builtin_amdgcn_permlane32_swap(__float_as_uint(m), __float_as_uint(m), false, false); return __uint_as_float(rr[0]) + __uint_as_float(rr[1]); }

__device__ __forceinline__ void task(const bf16_t* QKV, int colq, long kbase, int kstride, int qs0, int tlo, int thi, LAS unsigned char* vb,
                                     bf16_t* OGp  , float* LSEp  , int lane) {
    const int r32 = lane & 31, hi = lane >> 5;
    const long qrow = kbase + (long)(qs0 + r32) * kstride;
    bf16x8 qr[4];
#pragma unroll
    for (int d0 = 0; d0 < 4; ++d0) qr[d0] = *(const bf16x8*)(QKV + qrow * QKVW + colq + 16 * d0 + 8 * hi);
    const bf16_t* kcol = QKV + colq + 256 + 8 * hi;
    const bf16_t* vcol = QKV + colq + 512 + (lane & 7) * 8;
    const int vwoff = ((lane & 7) >> 2) * 2048 + ((lane & 7) & 3) * 16;
    const int vroff = ((lane >> 4) & 1) * 32 + (lane & 3) * 8 + (4 * hi + ((lane & 15) >> 2)) * 64;
    bf16x8 kf[4]; u32x4 vr[4];
    {
        const long kr = kbase + (long)(32 * tlo + r32) * kstride;
#pragma unroll
        for (int d0 = 0; d0 < 4; ++d0) kf[d0] = *(const bf16x8*)(kcol + kr * QKVW + 16 * d0);
#pragma unroll
        for (int i = 0; i < 4; ++i) { const long vrw = kbase + (long)(32 * tlo + i * 8 + (lane >> 3)) * kstride; vr[i] = *(const u32x4*)(vcol + vrw * QKVW); }
    }
    f32x16 o0 = {}, o1 = {}; float m_run = -1e30f, l_run = 0.f;
    for (int T = tlo; T <= thi; ++T) {
        LAS unsigned char* vbuf = vb + ((T & 1) ? 4096 : 0);
#pragma unroll
        for (int i = 0; i < 4; ++i) { const int row = i * 8 + (lane >> 3); *(LAS u32x4*)(vbuf + vwoff + (row >> 4) * 1024 + (row & 15) * 64) = vr[i]; }
        bf16x8 kn[4]; u32x4 vn[4];
        const int Tn = (T < thi) ? T + 1 : T;
        {
            const long kr = kbase + (long)(32 * Tn + r32) * kstride;
#pragma unroll
            for (int d0 = 0; d0 < 4; ++d0) kn[d0] = *(const bf16x8*)(kcol + kr * QKVW + 16 * d0);
#pragma unroll
            for (int i = 0; i < 4; ++i) { const long vrw = kbase + (long)(32 * Tn + i * 8 + (lane >> 3)) * kstride; vn[i] = *(const u32x4*)(vcol + vrw * QKVW); }
        }
        f32x16 p = {};
#pragma unroll
        for (int d0 = 0; d0 < 4; ++d0) p = __builtin_amdgcn_mfma_f32_32x32x16_bf16(kf[d0], qr[d0], p, 0, 0, 0);
        if (T == tlo || T == thi) {
            const int qs = qs0 + r32;
#pragma unroll
            for (int r = 0; r < 16; ++r) { const int ks = 32 * T + crow(r, hi); if (ks > qs || ks < qs - 128) p[r] = -1e30f; }
        }
        float rm = p[0];
#pragma unroll
        for (int r = 1; r < 16; ++r) rm = fmaxf(rm, p[r]);
        rm = swapmax(rm);
        const float mn = fmaxf(m_run, rm), alpha = __builtin_amdgcn_exp2f(m_run - mn); m_run = mn;
        float ls = 0.f;
#pragma unroll
        for (int r = 0; r < 16; ++r) { p[r] = __builtin_amdgcn_exp2f(p[r] - mn); ls += p[r]; }
        l_run = l_run * alpha + ls;
#pragma unroll
        for (int r = 0; r < 16; ++r) { o0[r] *= alpha; o1[r] *= alpha; }
        u32x4 pw0, pw1;
        pw0.x = cvt_pk_bf16(p[0], p[1]); pw0.y = cvt_pk_bf16(p[2], p[3]); pw0.z = cvt_pk_bf16(p[4], p[5]); pw0.w = cvt_pk_bf16(p[6], p[7]);
        pw1.x = cvt_pk_bf16(p[8], p[9]); pw1.y = cvt_pk_bf16(p[10], p[11]); pw1.z = cvt_pk_bf16(p[12], p[13]); pw1.w = cvt_pk_bf16(p[14], p[15]);
        const LAS unsigned char* vp = vbuf + vroff;
#define VFRAG(d0, s) ({ const s16x4 lo_ = vtr(vp + (d0) * 2048 + (s) * 1024), hi_ = vtr(vp + (d0) * 2048 + (s) * 1024 + 512); \
            (bf16x8){lo_[0], lo_[1], lo_[2], lo_[3], hi_[0], hi_[1], hi_[2], hi_[3]}; })
        o0 = __builtin_amdgcn_mfma_f32_32x32x16_bf16(VFRAG(0, 0), __builtin_bit_cast(bf16x8, pw0), o0, 0, 0, 0);
        o0 = __builtin_amdgcn_mfma_f32_32x32x16_bf16(VFRAG(0, 1), __builtin_bit_cast(bf16x8, pw1), o0, 0, 0, 0);
        o1 = __builtin_amdgcn_mfma_f32_32x32x16_bf16(VFRAG(1, 0), __builtin_bit_cast(bf16x8, pw0), o1, 0, 0, 0);
        o1 = __builtin_amdgcn_mfma_f32_32x32x16_bf16(VFRAG(1, 1), __builtin_bit_cast(bf16x8, pw1), o1, 0, 0, 0);
#undef VFRAG
#pragma unroll
        for (int d0 = 0; d0 < 4; ++d0) kf[d0] = kn[d0];
#pragma unroll
        for (int i = 0; i < 4; ++i) vr[i] = vn[i];
    }
    const float lt = swapsum(l_run), il = 1.0f / lt;
    bf16_t* op = OGp + qrow * 768;
#pragma unroll
    for (int a4 = 0; a4 < 4; ++a4) {
        u32x2 w0, w1;
        w0.x = cvt_pk_bf16(o0[4 * a4] * il, o0[4 * a4 + 1] * il); w0.y = cvt_pk_bf16(o0[4 * a4 + 2] * il, o0[4 * a4 + 3] * il);
        w1.x = cvt_pk_bf16(o1[4 * a4] * il, o1[4 * a4 + 1] * il); w1.y = cvt_pk_bf16(o1[4 * a4 + 2] * il, o1[4 * a4 + 3] * il);
        *(u32x2*)(op + 8 * a4 + 4 * hi) = w0; *(u32x2*)(op + 32 + 8 * a4 + 4 * hi) = w1;
    }
    if (hi == 0) LSEp[qrow * 12] = m_run + __builtin_amdgcn_logf(lt);
}

__device__ __forceinline__ void sample_task(const bf16_t* QKV, const float* cache, int W, int dil, int n, int h, int g, LAS float* sc, bf16_t* OG, float* LSE, int lane) {
    const long row = MP + n; const bf16_t* qp = QKV + row * QKVW + g * 768 + h * 64;
    const int dch = lane & 15, jl = lane >> 4;
    f32x4 q4; { const u32x2 w = *(const u32x2*)(qp + 4 * dch); q4 = (f32x4){bflo(w.x), bfhi(w.x), bflo(w.y), bfhi(w.y)}; }
    for (int it = 0; it < 33; ++it) {
        const int j = 4 * it + jl; f32x4 k4 = {0.f, 0.f, 0.f, 0.f};
        if (j == 0) { const u32x2 w = *(const u32x2*)(qp + 256 + 4 * dch); k4 = (f32x4){bflo(w.x), bfhi(w.x), bflo(w.y), bfhi(w.y)}; }
        else if (j <= 128) k4 = *(const f32x4*)(cache + ((size_t)(n * W + (W - dil * j)) * 2 + 0) * 256 + h * 64 + 4 * dch);
        float s = (k4[0] * q4[0] + k4[1] * q4[1]) + (k4[2] * q4[2] + k4[3] * q4[3]);
        s += __shfl_xor(s, 1); s += __shfl_xor(s, 2); s += __shfl_xor(s, 4); s += __shfl_xor(s, 8);
        if (dch == 0) sc[j] = (j <= 128) ? s : -1e30f;
    }
    LDS_WAIT(); asm volatile("" ::: "memory");
    float s0 = sc[lane], s1 = sc[lane + 64], s2 = (lane < 4) ? sc[lane + 128] : -1e30f;
    float mx = fmaxf(fmaxf(s0, s1), s2);
#pragma unroll
    for (int o = 1; o < 64; o <<= 1) mx = fmaxf(mx, __shfl_xor(mx, o));
    const float p0 = __builtin_amdgcn_exp2f(s0 - mx), p1 = __builtin_amdgcn_exp2f(s1 - mx), p2 = __builtin_amdgcn_exp2f(s2 - mx);
    const float l = wave_sum(p0 + p1 + p2);
    LDS_WAIT(); asm volatile("" ::: "memory");
    sc[lane] = p0; sc[lane + 64] = p1; if (lane < 4) sc[lane + 128] = p2;
    LDS_WAIT(); asm volatile("" ::: "memory");
    f32x4 ac = {0.f, 0.f, 0.f, 0.f};
    for (int it = 0; it < 33; ++it) {
        const int j = 4 * it + jl; f32x4 v4 = {0.f, 0.f, 0.f, 0.f}; const float pj = sc[j];
        if (j == 0) { const u32x2 w = *(const u32x2*)(qp + 512 + 4 * dch); v4 = (f32x4){bflo(w.x), bfhi(w.x), bflo(w.y), bfhi(w.y)}; }
        else if (j <= 128) v4 = *(const f32x4*)(cache + ((size_t)(n * W + (W - dil * j)) * 2 + 1) * 256 + h * 64 + 4 * dch);
        ac += v4 * pj;
    }
#pragma unroll
    for (int e = 0; e < 4; ++e) { ac[e] += __shfl_xor(ac[e], 16); ac[e] += __shfl_xor(ac[e], 32); }
    const float il = 1.0f / l;
    if (lane < 16) *(u32x2*)(OG + row * 768 + g * 256 + h * 64 + 4 * dch) = pack4(ac * il);
    if (lane == 0) LSE[row * 12 + g * 4 + h] = mx + __builtin_amdgcn_logf(l);
    LDS_WAIT(); asm volatile("" ::: "memory");
}

__device__ __forceinline__ void merge_row(const bf16_t* OG, const float* LSE, bf16_t* ATT, long row, int h, int ch) {
    const float l0 = LSE[row * 12 + h], l1 = LSE[row * 12 + 4 + h], l2 = LSE[row * 12 + 8 + h];
    const float mx = fmaxf(fmaxf(l0, l1), l2);
    float w0 = __builtin_amdgcn_exp2f(l0 - mx), w1 = __builtin_amdgcn_exp2f(l1 - mx), w2 = __builtin_amdgcn_exp2f(l2 - mx);
    const float inv = 1.0f / (w0 + w1 + w2); w0 *= inv; w1 *= inv; w2 *= inv;
    const bf16_t* p = OG + row * 768 + h * 64 + 8 * ch;
    const u32x4 a = *(const u32x4*)p, b = *(const u32x4*)(p + 256), c = *(const u32x4*)(p + 512);
    u32x4 o;
    o.x = cvt_pk_bf16(w0 * bflo(a.x) + w1 * bflo(b.x) + w2 * bflo(c.x), w0 * bfhi(a.x) + w1 * bfhi(b.x) + w2 * bfhi(c.x));
    o.y = cvt_pk_bf16(w0 * bflo(a.y) + w1 * bflo(b.y) + w2 * bflo(c.y), w0 * bfhi(a.y) + w1 * bfhi(b.y) + w2 * bfhi(c.y));
    o.z = cvt_pk_bf16(w0 * bflo(a.z) + w1 * bflo(b.z) + w2 * bflo(c.z), w0 * bfhi(a.z) + w1 * bfhi(b.z) + w2 * bfhi(c.z));
    o.w = cvt_pk_bf16(w0 * bflo(a.w) + w1 * bflo(b.w) + w2 * bflo(c.w), w0 * bfhi(a.w) + w1 * bfhi(b.w) + w2 * bfhi(c.w));
    *(u32x4*)(ATT + row * AW + h * 64 + 8 * ch) = o;
}
}

__device__ __forceinline__ void p4_mixers(const Frame& F, const Args& a) {
    unsigned char* ws = a.ws;
    const bf16_t* QKV = (const bf16_t*)(ws + WS_QKV); const bf16_t* U = (const bf16_t*)(ws + WS_U);
    bf16_t* OG = (bf16_t*)(a.out + O_YP); float* LSE = (float*)((unsigned char*)OG + OG_BYTES); bf16_t* ATT = (bf16_t*)(ws + WS_ATT); bf16_t* P = (bf16_t*)(ws + WS_P);
    const int lane = F.lane, wv = F.wave;
    for (int unit = F.vcu; unit < 256; unit += F.G) {
        const int b = unit >> 4, h = (unit >> 2) & 3, blk = unit & 3;
        if (unit < 128 && wv < 3) {
            const int n = unit >> 2, hh = unit & 3;
            const float* cache = (wv == 0) ? a.in[3] : (wv == 1) ? a.in[4] : a.in[5];
            att::sample_task(QKV, cache, 128 << (2 * wv), 1 << (2 * wv), n, hh, wv, (LAS float*)(F.lds + 65536 + wv * 1024), OG, LSE, lane);
        }
        LAS unsigned char* vb = F.lds + wv * 8192;
        const long tok0 = (long)b * SEQ;
#pragma unroll 1
        for (int g = 0; g < 3; ++g) {
            const int dil = 1 << (2 * g), ns = 512 / dil;
#pragma unroll 1
            for (int sub = 0; sub < 2; ++sub) {
                const int f = (2 * wv + sub) * 32;
                const int rho = f / ns, sl = f - rho * ns;
                const int qs0 = blk * ns + sl;
                const int tlo = (qs0 >= 128) ? (qs0 - 128) / 32 : 0, thi = qs0 / 32;
                att::task(QKV, g * 768 + h * 64, tok0 + rho, dil, qs0, tlo, thi, vb, OG + g * 256 + h * 64, LSE + g * 4 + h, lane);
            }
        }
        {
            const int gi = h, w = 2 << gi, ch = F.tid & 15, rg = F.tid >> 4, t0 = blk * 512 + rg * 16;
            const bf16_t* up = U + (size_t)tok0 * PW + gi * 128 + ch * 8; bf16_t* pp = P + (size_t)tok0 * PW + gi * 128 + ch * 8;
            float S[8] = {0.f, 0.f, 0.f, 0.f, 0.f, 0.f, 0.f, 0.f};
            for (int i = 1; i < w; ++i) { const int t = t0 - i; if (t >= 0) { const u32x4 x = *(const u32x4*)(up + (size_t)t * PW);
                S[0] += bflo(x.x); S[1] += bfhi(x.x); S[2] += bflo(x.y); S[3] += bfhi(x.y); S[4] += bflo(x.z); S[5] += bfhi(x.z); S[6] += bflo(x.w); S[7] += bfhi(x.w); } }
#pragma unroll 4
            for (int i = 0; i < 16; ++i) { const int t = t0 + i; const u32x4 x = *(const u32x4*)(up + (size_t)t * PW);
                const float xv[8] = {bflo(x.x), bfhi(x.x), bflo(x.y), bfhi(x.y), bflo(x.z), bfhi(x.z), bflo(x.w), bfhi(x.w)};
                const float ic = 1.0f / (float)((t + 1 < w) ? t + 1 : w); float pv[8];
#pragma unroll
                for (int e = 0; e < 8; ++e) { S[e] += xv[e]; pv[e] = S[e] * ic - xv[e]; }
                u32x4 o; o.x = cvt_pk_bf16(pv[0], pv[1]); o.y = cvt_pk_bf16(pv[2], pv[3]); o.z = cvt_pk_bf16(pv[4], pv[5]); o.w = cvt_pk_bf16(pv[6], pv[7]);
                *(u32x4*)(pp + (size_t)t * PW) = o;
                const int tb = t - w + 1; if (tb >= 0) { const u32x4 y = *(const u32x4*)(up + (size_t)tb * PW);
                    S[0] -= bflo(y.x); S[1] -= bfhi(y.x); S[2] -= bflo(y.y); S[3] -= bfhi(y.y); S[4] -= bflo(y.z); S[5] -= bfhi(y.z); S[6] -= bflo(y.w); S[7] -= bfhi(y.w); } }
        }
#pragma unroll 1
        for (int g = 0; g < 3; ++g) {
            const int W = 128 << (2 * g), tlo = SEQ - W; if (blk * 512 + 512 <= tlo) continue;
            float* ob = a.out + ((g == 0) ? O_KV128P : (g == 1) ? O_KV512P : O_KV2048P);
            for (int idx = F.tid; idx < 512 * 16; idx += 512) { const int which = idx >> 12, rl = (idx >> 3) & 511, ch = idx & 7, t = blk * 512 + rl;
                if (t >= tlo) { const u32x4 w = *(const u32x4*)(QKV + (size_t)(tok0 + t) * QKVW + g * 768 + (1 + which) * 256 + h * 64 + ch * 8);
                    float* d = ob + ((size_t)(b * W + (t - tlo)) * 2 + which) * 256 + h * 64 + ch * 8;
                    *(f32x4*)d = (f32x4){bflo(w.x), bfhi(w.x), bflo(w.y), bfhi(w.y)}; *(f32x4*)(d + 4) = (f32x4){bflo(w.z), bfhi(w.z), bflo(w.w), bfhi(w.w)}; } }
        }
        if (unit >= 128 && unit < 160) {
            const int n = unit - 128, c = F.tid, gi = c >> 7, w = 2 << gi;
            const float un = bf2f(U[(size_t)(MP + n) * PW + c]); float S = un; const float* sp = a.in[2] + (size_t)n * 15 * PW + c;
            for (int i = 1; i < w; ++i) S += sp[(size_t)(15 - i) * PW];
            const float pv = S / (float)w - un;
            P[(size_t)(MP + n) * PW + c] = (bf16_t)(cvt_pk_bf16(pv, 0.f) & 0xffffu);
        }
        asm volatile("s_waitcnt vmcnt(0)" ::: "memory");
        __syncthreads();
        { const int rl = F.tid >> 3, ch = F.tid & 7;
#pragma unroll 2
            for (int it = 0; it < 8; ++it) att::merge_row(OG, LSE, ATT, tok0 + blk * 512 + it * 64 + rl, h, ch);
            if (unit < 128 && F.tid < 8) att::merge_row(OG, LSE, ATT, MP + (unit >> 2), unit & 3, F.tid);
        }
        __syncthreads();
    }
}

__device__ __forceinline__ void p9_final(const Frame& F, const Args& a) {
    const float* ss3 = (const float*)(a.ws + WS_SSP) + 2 * SSP_STRIDE; const f32x4* g4 = (const f32x4*)a.in[21] + F.lane;
    const int gw = F.vcu * NWAVES + F.wave, NGW = F.G * NWAVES;
    f32x4 gv[4];
#pragma unroll
    for (int j = 0; j < 4; ++j) gv[j] = g4[64 * j];
    for (int m = gw; m < MP + NS; m += NGW) {
        const float* src = (m < MP) ? a.out + O_YP + (size_t)m * DM : (const float*)(a.ws + WS_XS) + (size_t)(m - MP) * DM;
        float* dst = (m < MP) ? a.out + O_YP + (size_t)m * DM : a.out + O_YS + (size_t)(m - MP) * DM;
        const float qp = (m < MP) ? (F.lane < 16 ? ss3[(size_t)F.lane * MT + m] : 0.f) : ((const float*)(a.ws + WS_SSS))[(2 * 64 + F.lane) * 32 + (m - MP)];
        const float rs = 1.0f / sqrtf(wave_sum(qp) * (1.0f / DM) + RMS_EPS);
        const f32x4* s4 = (const f32x4*)src + F.lane; f32x4* d4 = (f32x4*)dst + F.lane;
        f32x4 v[4];
#pragma unroll
        for (int j = 0; j < 4; ++j) v[j] = s4[64 * j];
#pragma unroll
        for (int j = 0; j < 4; ++j) d4[64 * j] = v[j] * rs * gv[j];
    }
}

constexpr int N_PHASES = 10;
__global__ void __launch_bounds__(NWAVES * 64, 2) hybrid_fwd(Args args) {
    extern __shared__ __attribute__((aligned(16))) unsigned char lds[];
    Frame F;
    F.lds = (LAS unsigned char*)lds;
    F.tid = threadIdx.x; F.lane = F.tid & 63; F.wave = __builtin_amdgcn_readfirstlane(F.tid >> 6);
    F.G = gridDim.x; { const int bx = blockIdx.x; F.vcu = (F.G % 8 == 0) ? (bx % 8) * (F.G / 8) + bx / 8 : bx; }
    unsigned char* ws = args.ws;
    gu32* ctl = (gu32*)(ws + WS_CTL);
    for (int u = F.tid; u < (LDS_BYTES - LDSCTL_OFF) / 4; u += NWAVES * 64) ((LAS unsigned*)(F.lds + LDSCTL_OFF))[u] = 0u;
    __syncthreads();
    XcdBarrier bar; bar.bar = (unsigned*)(ctl + CW_BAR); bar.x = 0; bar.st = nullptr;
    const int lo = args.ph_lo, hi = args.ph_hi;
    if (hi - lo > 1) bar = xcd_barrier_post((unsigned*)(ctl + CW_BAR), (volatile LAS unsigned*)(F.lds + MISC_OFF) + 8);
#define IN(k) (lo <= (k) && (k) < hi)
#define SEAM(k) do { if (IN(k) && IN((k) + 1)) xcd_barrier(bar); } while (0)
    float* ss0 = (float*)(ws + WS_CTL) + CW_SS; float* ssp = (float*)(ws + WS_SSP);
    bf16_t* XB = (bf16_t*)(ws + WS_XB); bf16_t* H = (bf16_t*)(ws + WS_H); float* XS = (float*)(ws + WS_XS);
    float* sss = (float*)(ws + WS_SSS);
    float* XRES = args.out + O_YP;

    if (IN(0)) { p0_prologue<7>(F, args); if (DIAG_REPEAT >= 10 && DIAG_REPEAT <= 12) { xcd_barrier(bar); p0_prologue<(1 << ((DIAG_REPEAT >= 10 ? DIAG_REPEAT : 10) - 10))>(F, args); } } SEAM(0);
#ifdef DIAG_DUMP_W
    if (IN(0) && !IN(1)) { xcd_barrier(bar);
        const size_t gt = (size_t)F.vcu * 512 + F.tid, NT = (size_t)F.G * 512; const bf16_t* Wd = (const bf16_t*)(ws + WS_W1UP); float* y = args.out + O_YP;
        for (size_t i = gt; i < (WS_XS - WS_W1UP) / 2; i += NT) y[i] = bf2f(Wd[i]); }
#endif

    if (IN(1)) {
        sk_up(F, XB, (const bf16_t*)(ws + WS_W1UP), H, ss0, nullptr);
        pg8::Gemm g{XB, (const bf16_t*)(ws + WS_W1UP), MP, 2 * FF, DM, (size_t)128 * DM, (size_t)FF * DM}; pg8::StaticOrder S; S.init(MP, 2 * FF, F.G, (int)blockIdx.x);
        EpiUp<1> E{H, ss0};
        TWICE(1, pg8::gemm_phase<EpiUp<1>, pg8::StaticOrder, true, true>(F.lds + RING_OFF, g, S, E));
    } SEAM(1);
    if (IN(2)) {
        sk_res<4>(F, H + (size_t)MP * FF, FF, (const bf16_t*)(ws + WS_W1DN), XS, XB + (size_t)MP * DM, sss, 0.5f);
        pg8::Gemm g{H, (const bf16_t*)(ws + WS_W1DN), MP, DM, FF, (size_t)256 * FF, (size_t)128 * FF}; pg8::StaticOrder S; S.init(MP, DM, F.G, (int)blockIdx.x);
        EpiRes<false, false> E{nullptr, XB, nullptr, XB, ssp, 0.5f};
        pg8::gemm_phase<EpiRes<false, false>, pg8::StaticOrder, true, true>(F.lds + RING_OFF, g, S, E);
    } SEAM(2);
    if (IN(3)) {
        sk_in(F, XB, (const bf16_t*)(ws + WS_WIN), sss, (bf16_t*)(ws + WS_U), (bf16_t*)(ws + WS_QKV), (bf16_t*)(ws + WS_G), args.out);
        pg8::Gemm g{XB, (const bf16_t*)(ws + WS_WIN), MP, INW, DM, (size_t)256 * DM, (size_t)128 * DM}; pg8::StaticOrder S; S.init(MP, INW, F.G, (int)blockIdx.x);
        EpiIn E{ssp, (bf16_t*)(ws + WS_U), (bf16_t*)(ws + WS_QKV), (bf16_t*)(ws + WS_G), args.out};
        TWICE(3, pg8::gemm_phase<EpiIn, pg8::StaticOrder, true, true>(F.lds + RING_OFF, g, S, E));
    } SEAM(3);
    if (IN(4)) { TWICE(4, p4_mixers(F, args)); } SEAM(4);
#ifdef DIAG_DUMP_P4
    if (IN(4) && !IN(5)) { xcd_barrier(bar);
        const size_t gt = (size_t)F.vcu * 512 + F.tid, NT = (size_t)F.G * 512; const bf16_t* ATTd = (const bf16_t*)(ws + WS_ATT); const bf16_t* Pd = (const bf16_t*)(ws + WS_P); float* y = args.out + O_YP;
        for (size_t i = gt; i < (size_t)(MP + NS) * AW; i += NT) y[i] = bf2f(ATTd[i]);
        for (size_t i = gt; i < (size_t)(MP + NS) * PW; i += NT) y[(size_t)(MP + NS) * AW + i] = bf2f(Pd[i]); }
#endif
    if (IN(5)) {
        sk_br(F, (const bf16_t*)(ws + WS_P), (const bf16_t*)(ws + WS_ATT), (const bf16_t*)(ws + WS_WCOMB), (const bf16_t*)(ws + WS_WAB), (const bf16_t*)(ws + WS_G), (bf16_t*)(ws + WS_MG));
        { pg8::Gemm g{(const bf16_t*)(ws + WS_P), (const bf16_t*)(ws + WS_WCOMB), MP, DM, PW, (size_t)256 * PW, (size_t)128 * PW}; pg8::StaticOrder S; S.init(MP, DM, F.G, (int)blockIdx.x);
          EpiBr<0> E{(const bf16_t*)(ws + WS_G), (bf16_t*)(ws + WS_T1), (bf16_t*)(ws + WS_MG)};
          pg8::gemm_phase<EpiBr<0>, pg8::StaticOrder, true, true>(F.lds + RING_OFF, g, S, E); }
        asm volatile("s_waitcnt vmcnt(0)" ::: "memory"); __syncthreads();
        { pg8::Gemm g{(const bf16_t*)(ws + WS_ATT), (const bf16_t*)(ws + WS_WAB), MP, DM, AW, (size_t)256 * AW, (size_t)128 * AW}; pg8::StaticOrder S; S.init(MP, DM, F.G, (int)blockIdx.x);
          EpiBr<1> E{(const bf16_t*)(ws + WS_G), (bf16_t*)(ws + WS_T1), (bf16_t*)(ws + WS_MG)};
          pg8::gemm_phase<EpiBr<1>, pg8::StaticOrder, true, true>(F.lds + RING_OFF, g, S, E); }
    } SEAM(5);
#ifdef DIAG_DUMP
    if (IN(DIAG_STOP - 1) && !IN(DIAG_STOP)) { xcd_barrier(bar);
        const size_t gt = (size_t)F.vcu * 512 + F.tid, NT = (size_t)F.G * 512; const bf16_t* MGd = (const bf16_t*)(ws + DIAG_DUMP_OFF); float* y = args.out + O_YP;
        for (size_t i = gt; i < (size_t)MP * DM; i += NT) y[i] = bf2f(MGd[i]); }
#endif
    if (IN(6)) {
        sk_res<2>(F, (const bf16_t*)(ws + WS_MG) + (size_t)MP * DM, DM, (const bf16_t*)(ws + WS_WO), XS, XB + (size_t)MP * DM, sss + 64 * 32, 1.0f);
        pg8::Gemm g{(const bf16_t*)(ws + WS_MG), (const bf16_t*)(ws + WS_WO), MP, DM, DM, (size_t)256 * DM, (size_t)128 * DM}; pg8::StaticOrder S; S.init(MP, DM, F.G, (int)blockIdx.x);
        EpiRes<false, false> E{nullptr, XB, nullptr, XB, ssp + SSP_STRIDE, 1.0f};
        pg8::gemm_phase<EpiRes<false, false>, pg8::StaticOrder, true, true>(F.lds + RING_OFF, g, S, E);
    } SEAM(6);
    if (IN(7)) {
        sk_up(F, XB, (const bf16_t*)(ws + WS_W2UP), H, nullptr, sss + 64 * 32);
        pg8::Gemm g{XB, (const bf16_t*)(ws + WS_W2UP), MP, 2 * FF, DM, (size_t)128 * DM, (size_t)FF * DM}; pg8::StaticOrder S; S.init(MP, 2 * FF, F.G, (int)blockIdx.x);
        EpiUp<16> E{H, ssp + SSP_STRIDE};
        TWICE(7, pg8::gemm_phase<EpiUp<16>, pg8::StaticOrder, true, true>(F.lds + RING_OFF, g, S, E));
    } SEAM(7);
    if (IN(8)) {
        sk_res<4>(F, H + (size_t)MP * FF, FF, (const bf16_t*)(ws + WS_W2DN), XS, nullptr, sss + 2 * 64 * 32, 0.5f);
        pg8::Gemm g{H, (const bf16_t*)(ws + WS_W2DN), MP, DM, FF, (size_t)256 * FF, (size_t)128 * FF}; pg8::StaticOrder S; S.init(MP, DM, F.G, (int)blockIdx.x);
        EpiRes<false, true> E{nullptr, XB, XRES, nullptr, ssp + 2 * SSP_STRIDE, 0.5f};
        pg8::gemm_phase<EpiRes<false, true>, pg8::StaticOrder, true, true>(F.lds + RING_OFF, g, S, E);
    } SEAM(8);
    if (IN(9)) { p9_final(F, args); }
#undef IN
#undef SEAM
}

extern "C" void kernel_launch(void* const* d_in, const int* in_sizes, int n_in, void* d_out, int out_size, void* d_ws, size_t ws_size, hipStream_t stream) {
    static int grid = 0;
    if (grid == 0) {
        if (n_in != 22 || in_sizes[0] != MP * DM || (size_t)out_size != O_END || ws_size < WS_END) {
            fprintf(stderr, "kernel_launch: unexpected shapes (n_in %d, in0 %d, out %d, ws %zu need %zu); nothing launched\n", n_in, n_in > 0 ? in_sizes[0] : -1, out_size, ws_size, (size_t)WS_END); grid = -1; return; }
        int dev = 0, cus = 0, per_cu = 0;
        if (hipGetDevice(&dev) != hipSuccess || hipDeviceGetAttribute(&cus, hipDeviceAttributeMultiprocessorCount, dev) != hipSuccess) { grid = -1; return; }
        if (hipFuncSetAttribute((const void*)hybrid_fwd, hipFuncAttributeMaxDynamicSharedMemorySize, LDS_BYTES) != hipSuccess) { fprintf(stderr, "kernel_launch: hipFuncSetAttribute failed\n"); grid = -1; return; }
        if (hipOccupancyMaxActiveBlocksPerMultiprocessor(&per_cu, (const void*)hybrid_fwd, NWAVES * 64, LDS_BYTES) != hipSuccess || per_cu < 1) {
            fprintf(stderr, "kernel_launch: occupancy query reports %d workgroups per CU\n", per_cu); per_cu = 1; }
        (void)hipGetLastError();
        grid = cus;
    }
    if (grid < 0) return;
#ifdef DIAG_POISON
    (void)hipMemsetAsync((char*)d_ws, 0xAA, WS_END, stream); (void)hipMemsetAsync((char*)d_out, 0xAA, O_END * 4, stream);
#endif
    if (hipMemsetAsync((char*)d_ws + WS_CTL, 0, CTL_ZERO_BYTES, stream) != hipSuccess) { fprintf(stderr, "kernel_launch: memset failed\n"); return; }
    Args a{};
    for (int i = 0; i < 22; ++i) a.in[i] = (const float*)d_in[i];
    a.out = (float*)d_out; a.ws = (unsigned char*)d_ws;
    constexpr int NL = MK_N_LAUNCHES;
    for (int li = 0; li < NL; ++li) {
        a.ph_lo = (NL == 1) ? 0 : li; a.ph_hi = (NL == 1) ? N_PHASES : li + 1;
#ifdef DIAG_STOP
        a.ph_hi = DIAG_STOP;
#endif
        hipLaunchKernelGGL(hybrid_fwd, dim3(grid), dim3(NWAVES * 64), LDS_BYTES, stream, a);
        const hipError_t le = hipPeekAtLastError();
        if (le != hipSuccess) { fprintf(stderr, "kernel_launch: launch %d failed: %s\n", li, hipGetErrorName(le)); break; }
    }
}
```
